# Optimizing an MI355X kernel written in HIP

```python
import math
import jax, jax.numpy as jnp
from jax import lax
import numpy as np

D_MODEL = 1024
BATCH = 8
SEQ = 4096
DEPTH = 2

ATTN_HEADS = 8
ATTN_KV_HEADS = 2
HEAD_DIM = 64
WINDOW = 128
ATTN_BLOCK = 128
HGRN_HEADS = 4
HGRN_KEY_DIM = 64
HGRN_VAL_DIM = 64
HGRN_CHUNK = 64
S5_GROUPS = 16
S5_GROUP_CH = 16
S5_STATE = 64
D_FF = 2816
EPS = 1e-6

ATTN_WIDTH = ATTN_HEADS * HEAD_DIM
KV_WIDTH = ATTN_KV_HEADS * HEAD_DIM
HGRN_KEY_WIDTH = HGRN_HEADS * HGRN_KEY_DIM
HGRN_WIDTH = HGRN_HEADS * HGRN_VAL_DIM
S5_WIDTH = S5_GROUPS * S5_GROUP_CH
MIX_WIDTH = ATTN_WIDTH + HGRN_WIDTH + S5_WIDTH
IN_PROJ_WIDTH = ATTN_WIDTH + 2 * KV_WIDTH + 2 * HGRN_KEY_WIDTH + 2 * HGRN_WIDTH + S5_WIDTH

kernel_name = "hymba_swa_hgrn2_s5_macaron"


def rms_norm(x, g):
    xf = x.astype(jnp.float32)
    y = xf * lax.rsqrt(jnp.mean(xf * xf, axis=-1, keepdims=True) + EPS)
    return (y * g.astype(jnp.float32)).astype(x.dtype)


def swiglu(x, w_gate, w_up, w_down):
    return (jax.nn.silu(x @ w_gate) * (x @ w_up)) @ w_down


def alibi_slopes(n_heads):
    return 2.0 ** (-8.0 * (jnp.arange(n_heads, dtype=jnp.float32) + 1.0) / n_heads)


def sliding_window_attention(q, k, v, sinks):
    b_, l_, h_, d_ = q.shape
    hkv = k.shape[2]
    grp = h_ // hkv
    nb = l_ // ATTN_BLOCK
    qb = q.reshape(b_, nb, ATTN_BLOCK, hkv, grp, d_)
    kb = k.reshape(b_, nb, ATTN_BLOCK, hkv, d_)
    vb = v.reshape(b_, nb, ATTN_BLOCK, hkv, d_)

    def with_prev(t):
        prev = jnp.pad(t[:, :-1], ((0, 0), (1, 0), (0, 0), (0, 0), (0, 0)))
        return jnp.concatenate([prev, t], axis=2)

    kk, vv = with_prev(kb), with_prev(vb)
    s = jnp.einsum('bnqhgd,bnkhd->bnhgqk', qb, kk).astype(jnp.float32) * (1.0 / math.sqrt(d_))
    qi = jnp.arange(ATTN_BLOCK)
    ki = jnp.arange(2 * ATTN_BLOCK)
    rel = qi[:, None] + ATTN_BLOCK - ki[None, :]
    in_win = (rel >= 0) & (rel < WINDOW)
    key_pos = jnp.arange(nb)[:, None] * ATTN_BLOCK - ATTN_BLOCK + ki[None, :]
    mask = in_win[None] & (key_pos >= 0)[:, None, :]
    slopes = alibi_slopes(h_).reshape(hkv, grp)
    s = s - slopes[:, :, None, None] * rel.astype(jnp.float32)
    s = jnp.where(mask[None, :, None, None], s, -jnp.inf)
    sink = sinks.astype(jnp.float32).reshape(hkv, grp)[:, :, None, None]
    m = jnp.maximum(jnp.max(s, axis=-1, keepdims=True), sink)
    p = jnp.exp(s - m)
    denom = jnp.sum(p, axis=-1, keepdims=True) + jnp.exp(sink - m)
    p = (p / denom).astype(v.dtype)
    o = jnp.einsum('bnhgqk,bnkhd->bnqhgd', p, vv)
    return o.reshape(b_, l_, h_ * d_)


def hgrn2(q_raw, f_raw, i_raw, g_raw, lb, norm_gain):
    b_, l_, _ = q_raw.shape
    nc = l_ // HGRN_CHUNK
    lbf = lb.astype(jnp.float32)
    zf = f_raw.astype(jnp.float32)
    log_f = jnp.logaddexp(jnp.log(lbf), jnp.log1p(-lbf) + jax.nn.log_sigmoid(zf))
    k = (1.0 - lbf) * jax.nn.sigmoid(-zf)
    q = jax.nn.silu(q_raw)

    def to_chunks(t, d):
        return t.reshape(b_, nc, HGRN_CHUNK, HGRN_HEADS, d).transpose(1, 0, 3, 2, 4)

    qc = to_chunks(q, HGRN_KEY_DIM)
    kc = to_chunks(k, HGRN_KEY_DIM)
    lfc = to_chunks(log_f, HGRN_KEY_DIM)
    vc = to_chunks(i_raw, HGRN_VAL_DIM)
    tri = jnp.tril(jnp.ones((HGRN_CHUNK, HGRN_CHUNK), dtype=bool))

    def step(state, xs):
        qt, kt, vt, lft = xs
        bcum = jnp.cumsum(lft, axis=2)
        inter = jnp.einsum('bhtk,bhkv->bhtv', qt * jnp.exp(bcum), state)
        diff = bcum[:, :, :, None, :] - bcum[:, :, None, :, :]
        decay = jnp.exp(jnp.where(tri[None, None, :, :, None], diff, -jnp.inf))
        att = jnp.einsum('bhtk,bhsk,bhtsk->bhts', qt, kt, decay)
        intra = jnp.einsum('bhts,bhsv->bhtv', att, vt)
        b_last = bcum[:, :, -1, :]
        new_state = state * jnp.exp(b_last)[..., None] + jnp.einsum(
            'bhsk,bhsv->bhkv', kt * jnp.exp(b_last[:, :, None, :] - bcum), vt)
        return new_state, inter + intra

    s0 = jnp.zeros((b_, HGRN_HEADS, HGRN_KEY_DIM, HGRN_VAL_DIM), jnp.float32)
    _, oc = lax.scan(step, s0, (qc, kc, vc, lfc))
    o = oc.transpose(1, 0, 3, 2, 4).reshape(b_, l_, HGRN_HEADS, HGRN_VAL_DIM)
    o = o * lax.rsqrt(jnp.mean(o * o, axis=-1, keepdims=True) + EPS)
    o = o * norm_gain.astype(jnp.float32).reshape(HGRN_HEADS, HGRN_VAL_DIM)
    o = o.reshape(b_, l_, HGRN_WIDTH) * jax.nn.silu(g_raw.astype(jnp.float32))
    return o.astype(q_raw.dtype)


def s5_ssm(u, a_re, a_im, log_dt, b_re, b_im, c_re, c_im, d_skip, glu_w, glu_b):
    b_, l_, _ = u.shape
    f32 = jnp.float32
    uf = u.astype(f32).reshape(b_, l_, S5_GROUPS, S5_GROUP_CH)
    ar, ai = a_re.astype(f32), a_im.astype(f32)
    dt = jnp.exp(log_dt.astype(f32))[:, None]
    mag = jnp.exp(ar * dt)
    abar_re, abar_im = mag * jnp.cos(ai * dt), mag * jnp.sin(ai * dt)
    nr, ni = abar_re - 1.0, abar_im
    den = ar * ar + ai * ai
    z_re = (nr * ar + ni * ai) / den
    z_im = (ni * ar - nr * ai) / den
    br, bi = b_re.astype(f32), b_im.astype(f32)
    bbar_re = z_re[..., None] * br - z_im[..., None] * bi
    bbar_im = z_re[..., None] * bi + z_im[..., None] * br
    bu_re = jnp.einsum('blgc,gpc->blgp', uf, bbar_re)
    bu_im = jnp.einsum('blgc,gpc->blgp', uf, bbar_im)
    a_re_t = jnp.broadcast_to(abar_re, bu_re.shape)
    a_im_t = jnp.broadcast_to(abar_im, bu_im.shape)

    def combine(e1, e2):
        a1r, a1i, b1r, b1i = e1
        a2r, a2i, b2r, b2i = e2
        return (a2r * a1r - a2i * a1i,
                a2r * a1i + a2i * a1r,
                a2r * b1r - a2i * b1i + b2r,
                a2r * b1i + a2i * b1r + b2i)

    _, _, x_re, x_im = lax.associative_scan(combine, (a_re_t, a_im_t, bu_re, bu_im), axis=1)
    y = (jnp.einsum('blgp,gcp->blgc', x_re, c_re.astype(f32))
         - jnp.einsum('blgp,gcp->blgc', x_im, c_im.astype(f32))
         + d_skip.astype(f32) * uf)
    z = jax.nn.gelu(y.reshape(b_, l_, S5_WIDTH))
    out = z * jax.nn.sigmoid(z @ glu_w.astype(f32) + glu_b.astype(f32))
    return out.astype(u.dtype)


def setup_inputs(seed: int = 0) -> dict:
    key = jax.random.key(seed)
    ks = jax.random.split(key, 32)
    f32 = jnp.float32
    nrm = lambda k, shape, scale: jax.random.normal(k, shape, f32) * scale
    gain = lambda k, shape: 1.0 + 0.02 * jax.random.normal(k, shape, f32)
    return {
        "x": jax.random.normal(ks[0], (BATCH, SEQ, D_MODEL), f32),
        "norm_ffn1": gain(ks[1], (DEPTH, D_MODEL)),
        "ffn1_w_gate": nrm(ks[2], (DEPTH, D_MODEL, D_FF), D_MODEL ** -0.5),
        "ffn1_w_up": nrm(ks[3], (DEPTH, D_MODEL, D_FF), D_MODEL ** -0.5),
        "ffn1_w_down": nrm(ks[4], (DEPTH, D_FF, D_MODEL), D_FF ** -0.5),
        "norm_mix": gain(ks[5], (DEPTH, D_MODEL)),
        "w_in": nrm(ks[6], (DEPTH, D_MODEL, IN_PROJ_WIDTH), D_MODEL ** -0.5),
        "attn_sinks": nrm(ks[7], (DEPTH, ATTN_HEADS), 1.0),
        "hgrn_lb_logits": nrm(ks[8], (DEPTH, HGRN_KEY_WIDTH), 1.0),
        "hgrn_norm": gain(ks[9], (DEPTH, HGRN_WIDTH)),
        "s5_a_re": -0.5 + 0.01 * jax.random.normal(ks[10], (DEPTH, S5_GROUPS, S5_STATE), f32),
        "s5_a_im": jnp.pi * jnp.arange(S5_STATE, dtype=f32) + 0.01 * jax.random.normal(ks[11], (DEPTH, S5_GROUPS, S5_STATE), f32),
        "s5_log_dt": jax.random.uniform(ks[12], (DEPTH, S5_GROUPS), f32, math.log(1e-3), math.log(1e-1)),
        "s5_b_re": nrm(ks[13], (DEPTH, S5_GROUPS, S5_STATE, S5_GROUP_CH), (2 * S5_GROUP_CH) ** -0.5),
        "s5_b_im": nrm(ks[14], (DEPTH, S5_GROUPS, S5_STATE, S5_GROUP_CH), (2 * S5_GROUP_CH) ** -0.5),
        "s5_c_re": nrm(ks[15], (DEPTH, S5_GROUPS, S5_GROUP_CH, S5_STATE), (S5_STATE / 2) ** -0.5),
        "s5_c_im": nrm(ks[16], (DEPTH, S5_GROUPS, S5_GROUP_CH, S5_STATE), (S5_STATE / 2) ** -0.5),
        "s5_d": nrm(ks[17], (DEPTH, S5_GROUPS, S5_GROUP_CH), 1.0),
        "s5_glu_w": nrm(ks[18], (DEPTH, S5_WIDTH, S5_WIDTH), S5_WIDTH ** -0.5),
        "s5_glu_b": nrm(ks[19], (DEPTH, S5_WIDTH), 0.01),
        "w_out": nrm(ks[20], (DEPTH, MIX_WIDTH, D_MODEL), MIX_WIDTH ** -0.5),
        "norm_ffn2": gain(ks[21], (DEPTH, D_MODEL)),
        "ffn2_w_gate": nrm(ks[22], (DEPTH, D_MODEL, D_FF), D_MODEL ** -0.5),
        "ffn2_w_up": nrm(ks[23], (DEPTH, D_MODEL, D_FF), D_MODEL ** -0.5),
        "ffn2_w_down": nrm(ks[24], (DEPTH, D_FF, D_MODEL), D_FF ** -0.5),
        "norm_final": gain(ks[25], (D_MODEL,)),
    }


def reference(x, norm_ffn1, ffn1_w_gate, ffn1_w_up, ffn1_w_down, norm_mix, w_in, attn_sinks,
              hgrn_lb_logits, hgrn_norm, s5_a_re, s5_a_im, s5_log_dt, s5_b_re, s5_b_im,
              s5_c_re, s5_c_im, s5_d, s5_glu_w, s5_glu_b, w_out, norm_ffn2, ffn2_w_gate,
              ffn2_w_up, ffn2_w_down, norm_final):
    b_, l_, _ = x.shape
    lbs = jnp.cumsum(jax.nn.softmax(hgrn_lb_logits.astype(jnp.float32), axis=0), axis=0)
    lbs = lbs - lbs[0:1]
    sizes = [ATTN_WIDTH, KV_WIDTH, KV_WIDTH, HGRN_KEY_WIDTH, HGRN_KEY_WIDTH, HGRN_WIDTH, HGRN_WIDTH, S5_WIDTH]
    cuts = [int(c) for c in np.cumsum(sizes)[:-1]]
    for layer in range(DEPTH):
        x = x + 0.5 * swiglu(rms_norm(x, norm_ffn1[layer]), ffn1_w_gate[layer], ffn1_w_up[layer], ffn1_w_down[layer])
        u = rms_norm(x, norm_mix[layer]) @ w_in[layer]
        q_a, k_a, v_a, q_b, f_b, i_b, g_b, u_c = jnp.split(u, cuts, axis=-1)
        y_a = sliding_window_attention(
            q_a.reshape(b_, l_, ATTN_HEADS, HEAD_DIM),
            k_a.reshape(b_, l_, ATTN_KV_HEADS, HEAD_DIM),
            v_a.reshape(b_, l_, ATTN_KV_HEADS, HEAD_DIM),
            attn_sinks[layer])
        y_b = hgrn2(q_b, f_b, i_b, g_b, lbs[layer], hgrn_norm[layer])
        y_c = s5_ssm(u_c, s5_a_re[layer], s5_a_im[layer], s5_log_dt[layer], s5_b_re[layer], s5_b_im[layer],
                     s5_c_re[layer], s5_c_im[layer], s5_d[layer], s5_glu_w[layer], s5_glu_b[layer])
        x = x + jnp.concatenate([y_a, y_b, y_c], axis=-1) @ w_out[layer]
        x = x + 0.5 * swiglu(rms_norm(x, norm_ffn2[layer]), ffn2_w_gate[layer], ffn2_w_up[layer], ffn2_w_down[layer])
    return rms_norm(x, norm_final)
```

```cpp
#include <hip/hip_runtime.h>
#include <hip/hip_cooperative_groups.h>
#include <cstdio>
#include <cstdint>
namespace cg = cooperative_groups;

constexpr int DM = 1024, BATCH = 8, SEQ = 4096, DEPTH = 2, MTOK = BATCH * SEQ;
constexpr int DFF = 2816, NGU = 2 * DFF, NIN = 2048;
constexpr float EPS = 1e-6f;
constexpr int UC_Q = 0, UC_K = 512, UC_V = 640, UC_HQ = 768, UC_HF = 1024, UC_HI = 1280, UC_HG = 1536, UC_S5 = 1792;
constexpr int YC_A = 0, YC_B = 512, YC_C = 768;

#define LAS __attribute__((address_space(3)))
typedef unsigned short bf16_t;
typedef short bf16x8 __attribute__((ext_vector_type(8)));
typedef short s16x4 __attribute__((ext_vector_type(4)));
typedef float f32x4 __attribute__((ext_vector_type(4)));
typedef float f32x2 __attribute__((ext_vector_type(2)));
typedef float f32x16 __attribute__((ext_vector_type(16)));
typedef unsigned u32x4 __attribute__((ext_vector_type(4)));
typedef unsigned u32x2 __attribute__((ext_vector_type(2)));

__device__ __forceinline__ unsigned f2bf(float f) { unsigned u = __builtin_bit_cast(unsigned, f); return (u + 0x7fffu + ((u >> 16) & 1u)) >> 16; }
__device__ __forceinline__ unsigned pk2(float lo, float hi) { return f2bf(lo) | (f2bf(hi) << 16); }
__device__ __forceinline__ float bf_lo(unsigned w) { return __builtin_bit_cast(float, w << 16); }
__device__ __forceinline__ float bf_hi(unsigned w) { return __builtin_bit_cast(float, w & 0xffff0000u); }
__device__ __forceinline__ float sigmoidf_(float x) { return __builtin_amdgcn_rcpf(1.0f + __expf(-x)); }
__device__ __forceinline__ float siluf_(float x) { return x * __builtin_amdgcn_rcpf(1.0f + __expf(-x)); }
__device__ __forceinline__ float gelu_tanh(float x) { const float u = 1.5957691216057308f * (x + 0.044715f * x * x * x); return x * __builtin_amdgcn_rcpf(1.0f + __expf(-u)); }
#define LDS_WAIT() asm volatile("s_waitcnt lgkmcnt(0)" ::: "memory")
#define LDS_BARRIER() do { asm volatile("s_waitcnt lgkmcnt(0)" ::: "memory"); __builtin_amdgcn_s_barrier(); asm volatile("" ::: "memory"); } while (0)

namespace pg8 {
#define PG8_LAS __attribute__((address_space(3)))
typedef unsigned short bf16_t;
typedef short bf16x8 __attribute__((ext_vector_type(8)));
typedef float f32x4 __attribute__((ext_vector_type(4)));
typedef unsigned u32x4 __attribute__((ext_vector_type(4)));
constexpr int BM = 256, BK = 64, HALF = 128, HTB = HALF * BK * 2  , STAGE_BYTES = 8 * HTB, NXCD = 8, WGM = 8;

__host__ __device__ __forceinline__ int lds_byte(int r, int c) { const int st = (r >> 4) * 2 + (c >> 5), rr = r & 15, cc = c & 31, ob = rr * 64 + cc * 2; return st * 1024 + (ob ^ (((ob >> 9) & 1) << 5)); }
__host__ __device__ __forceinline__ void stage_rc(int b, int& R, int& C) { const int st = b / 1024, sb = b % 1024, swz = sb ^ (((sb >> 9) & 1) << 5); R = (st >> 1) * 16 + swz / 64; C = (st & 1) * 32 + (swz % 64) / 2; }
__host__ __device__ __forceinline__ int perm32(int rho) { const int n = rho >> 4, i = rho & 15; return 8 * (i >> 2) + 4 * n + (i & 3); }

struct Unit { int pm, pn; };
struct Gemm { const bf16_t* A; const bf16_t* Bt; int M, N, K; };

struct StaticOrder {
    int nM, nN, nwg, G, c;
    __host__ __device__ void init(int M, int N, int G_, int c_) { nM = M / BM; nN = N / BM; nwg = nM * nN; G = G_; c = c_; }
    __host__ __device__ bool next(int i, Unit& u) const {
        const long L = (long)i * G + c; if (L >= nwg) return false;
        int wgid = (int)L; { const int q = nwg / NXCD, r = nwg % NXCD, xcd = wgid % NXCD, off = wgid / NXCD; wgid = (xcd < r ? xcd * (q + 1) : r * (q + 1) + (xcd - r) * q) + off; }
        const int nig = WGM * nN, gid = wgid / nig, fm = gid * WGM, gsz = (nM - fm) < WGM ? (nM - fm) : WGM;
        u.pm = fm + ((wgid % nig) % gsz); u.pn = (wgid % nig) / gsz; return true;
    }
    __device__ __forceinline__ void a_ready(const Unit&) const {}
    __device__ __forceinline__ void done(const Unit&) const {}
};

__device__ __forceinline__ unsigned cvt_pk_bf16(float lo, float hi) { unsigned r; asm volatile("v_cvt_pk_bf16_f32 %0, %1, %2" : "=v"(r) : "v"(lo), "v"(hi)); return r; }
__device__ __forceinline__ float row_rinv(const float* ssq, int row) {
    const f32x4 p = *(const f32x4*)(ssq + 4 * (size_t)row);
    return __builtin_amdgcn_rsqf(((p[0] + p[1]) + (p[2] + p[3])) * (1.0f / DM) + EPS);
}
constexpr int RINV_SLOT_BYTES = 4096;
struct RinvOrder : StaticOrder {
    const float* ssq; PG8_LAS unsigned char* tab; mutable int par;
    __device__ __forceinline__ void a_ready(const Unit& u) const {
        int t_ = threadIdx.x; asm volatile("" : "+v"(t_));
        const int wave = __builtin_amdgcn_readfirstlane(t_ >> 6), lane = t_ & 63;
        if (wave < 4) __builtin_amdgcn_global_load_lds((const unsigned*)(ssq + 4 * (size_t)(u.pm * BM + wave * 64 + lane)), (PG8_LAS unsigned*)(tab + par * RINV_SLOT_BYTES + wave * 1024), 16, 0, 0);
        par ^= 1;
    }
};
__device__ __forceinline__ float row_rinv_lds(const PG8_LAS unsigned char* slot, int rowlocal) {
    const f32x4 p = *(const PG8_LAS f32x4*)(slot + 16 * rowlocal);
    return __builtin_amdgcn_rsqf(((p[0] + p[1]) + (p[2] + p[3])) * (1.0f / DM) + EPS);
}
struct EpiSwiglu {
    static constexpr bool PERM = true, AFTER_DRAIN = false;
    bf16_t* O; PG8_LAS unsigned char* tab; mutable int par;
    __device__ __forceinline__ void operator()(const f32x4 (&acc)[2][2][4][2], const Unit& u, int wr, int wc, int fr, int fq) const {
        const int row0 = u.pm * BM + wr * 64 + fr, col0 = u.pn * HALF + wc * 32 + 8 * fq;
        const PG8_LAS unsigned char* slot = tab + par * RINV_SLOT_BYTES; par ^= 1;
        float rv[2][4];
#pragma unroll
        for (int ai = 0; ai < 2; ++ai)
#pragma unroll
            for (int m = 0; m < 4; ++m) rv[ai][m] = row_rinv_lds(slot, ai * HALF + wr * 64 + m * 16 + fr);
#pragma unroll
        for (int ai = 0; ai < 2; ++ai)
#pragma unroll
            for (int m = 0; m < 4; ++m) {
                const int row = row0 + ai * HALF + m * 16; const float ri = rv[ai][m];
                f32x4 h[2];
#pragma unroll
                for (int n = 0; n < 2; ++n)
#pragma unroll
                    for (int j = 0; j < 4; ++j) { const float g = acc[ai][0][m][n][j] * ri, up = acc[ai][1][m][n][j] * ri; h[n][j] = g * __builtin_amdgcn_rcpf(1.0f + __expf(-g)) * up; }
                u32x4 w; w.x = cvt_pk_bf16(h[0][0], h[0][1]); w.y = cvt_pk_bf16(h[0][2], h[0][3]); w.z = cvt_pk_bf16(h[1][0], h[1][1]); w.w = cvt_pk_bf16(h[1][2], h[1][3]);
                *(u32x4*)(O + (size_t)row * DFF + col0) = w;
            }
    }
};
struct EpiScaleBf16 {
    static constexpr bool PERM = true, AFTER_DRAIN = false;
    bf16_t* O; int ldc; PG8_LAS unsigned char* tab; mutable int par;
    __device__ __forceinline__ void operator()(const f32x4 (&acc)[2][2][4][2], const Unit& u, int wr, int wc, int fr, int fq) const {
        const int row0 = u.pm * BM + wr * 64 + fr, col0 = u.pn * BM + wc * 32 + 8 * fq;
        const PG8_LAS unsigned char* slot = tab + par * RINV_SLOT_BYTES; par ^= 1;
        float rv[2][4];
#pragma unroll
        for (int ai = 0; ai < 2; ++ai)
#pragma unroll
            for (int m = 0; m < 4; ++m) rv[ai][m] = row_rinv_lds(slot, ai * HALF + wr * 64 + m * 16 + fr);
#pragma unroll
        for (int ai = 0; ai < 2; ++ai)
#pragma unroll
            for (int m = 0; m < 4; ++m) {
                const int row = row0 + ai * HALF + m * 16; const float ri = rv[ai][m];
#pragma unroll
                for (int bj = 0; bj < 2; ++bj) { const f32x4 v0 = acc[ai][bj][m][0] * ri, v1 = acc[ai][bj][m][1] * ri;
                    u32x4 w; w.x = cvt_pk_bf16(v0[0], v0[1]); w.y = cvt_pk_bf16(v0[2], v0[3]); w.z = cvt_pk_bf16(v1[0], v1[1]); w.w = cvt_pk_bf16(v1[2], v1[3]);
                    *(u32x4*)(O + (size_t)row * ldc + col0 + bj * HALF) = w; }
            }
    }
};
struct EpiResid {
    static constexpr bool PERM = true, AFTER_DRAIN = false;
    const float* res; float* out; bf16_t* xb; float* ssq_out; float scale; PG8_LAS float* scr;
    __device__ __forceinline__ void operator()(const f32x4 (&acc)[2][2][4][2], const Unit& u, int wr, int wc, int fr, int fq) const {
        const int row0 = u.pm * BM + wr * 64 + fr, col0 = u.pn * BM + wc * 32 + 8 * fq;
#pragma unroll
        for (int ai = 0; ai < 2; ++ai)
#pragma unroll
            for (int m = 0; m < 4; ++m) {
                const int row = row0 + ai * HALF + m * 16; const size_t off = (size_t)row * DM + col0; float ss = 0.f;
#pragma unroll
                for (int bj = 0; bj < 2; ++bj) {
                    const f32x4 r0 = *(const f32x4*)(res + off + bj * HALF), r1 = *(const f32x4*)(res + off + bj * HALF + 4);
                    const f32x4 v0 = r0 + acc[ai][bj][m][0] * scale, v1 = r1 + acc[ai][bj][m][1] * scale;
                    *(f32x4*)(out + off + bj * HALF) = v0; *(f32x4*)(out + off + bj * HALF + 4) = v1;
                    ss += (v0[0] * v0[0] + v0[1] * v0[1]) + (v0[2] * v0[2] + v0[3] * v0[3]) + (v1[0] * v1[0] + v1[1] * v1[1]) + (v1[2] * v1[2] + v1[3] * v1[3]);
                    u32x4 w; w.x = cvt_pk_bf16(v0[0], v0[1]); w.y = cvt_pk_bf16(v0[2], v0[3]); w.z = cvt_pk_bf16(v1[0], v1[1]); w.w = cvt_pk_bf16(v1[2], v1[3]);
                    if (xb) *(u32x4*)(xb + off + bj * HALF) = w; }
                ss += __shfl_xor(ss, 16); ss += __shfl_xor(ss, 32);
                if (fq == 0) scr[(ai * HALF + wr * 64 + m * 16 + fr) * 4 + wc] = ss;
            }
        asm volatile("s_waitcnt lgkmcnt(0)" ::: "memory"); __builtin_amdgcn_s_barrier(); asm volatile("" ::: "memory");
        const int tid = threadIdx.x;
        if (tid < BM) { const f32x4 p = *(const PG8_LAS f32x4*)(scr + tid * 4); ssq_out[4 * (size_t)(u.pm * BM + tid) + u.pn] = (p[0] + p[1]) + (p[2] + p[3]); }
    }
};


struct EpiResidFinal {
    static constexpr bool PERM = true, AFTER_DRAIN = false;
    const float* res; float* out; const float* gain; float* ssq_x; unsigned* cnt; float scale; PG8_LAS float* scr; PG8_LAS float* rsc;
    __device__ __forceinline__ void operator()(f32x4 (&acc)[2][2][4][2], const Unit& u, int wr, int wc, int fr, int fq) const {
        const int row0 = u.pm * BM + wr * 64 + fr, col0 = u.pn * BM + wc * 32 + 8 * fq;
#pragma unroll
        for (int ai = 0; ai < 2; ++ai)
#pragma unroll
            for (int m = 0; m < 4; ++m) {
                const int row = row0 + ai * HALF + m * 16; const size_t off = (size_t)row * DM + col0; float ss = 0.f;
#pragma unroll
                for (int bj = 0; bj < 2; ++bj) {
                    const f32x4 r0 = *(const f32x4*)(res + off + bj * HALF), r1 = *(const f32x4*)(res + off + bj * HALF + 4);
                    const f32x4 v0 = r0 + acc[ai][bj][m][0] * scale, v1 = r1 + acc[ai][bj][m][1] * scale;
                    acc[ai][bj][m][0] = v0; acc[ai][bj][m][1] = v1;
                    ss += (v0[0] * v0[0] + v0[1] * v0[1]) + (v0[2] * v0[2] + v0[3] * v0[3]) + (v1[0] * v1[0] + v1[1] * v1[1]) + (v1[2] * v1[2] + v1[3] * v1[3]); }
                ss += __shfl_xor(ss, 16); ss += __shfl_xor(ss, 32);
                if (fq == 0) scr[(ai * HALF + wr * 64 + m * 16 + fr) * 4 + wc] = ss;
            }
        asm volatile("s_waitcnt lgkmcnt(0)" ::: "memory"); __builtin_amdgcn_s_barrier(); asm volatile("" ::: "memory");
        int t_ = threadIdx.x; asm volatile("" : "+v"(t_)); const int tid = t_, lane = tid & 63;
        unsigned* pc = cnt + 64 * u.pm;
        if (tid < BM) {
            const f32x4 p = *(const PG8_LAS f32x4*)(scr + tid * 4);
            __hip_atomic_store(ssq_x + 4 * (size_t)(u.pm * BM + tid) + u.pn, (p[0] + p[1]) + (p[2] + p[3]), __ATOMIC_RELAXED, __HIP_MEMORY_SCOPE_AGENT);
            asm volatile("s_waitcnt vmcnt(0)" ::: "memory");
            if (lane == 0) __hip_atomic_fetch_add(pc, 1u, __ATOMIC_RELEASE, __HIP_MEMORY_SCOPE_AGENT);
        }
        if (tid == 0) {
            unsigned spins = 0;
            while (__hip_atomic_load(pc, __ATOMIC_RELAXED, __HIP_MEMORY_SCOPE_AGENT) < 16u && ++spins < (1u << 22)) __builtin_amdgcn_s_sleep(2);
            __builtin_amdgcn_fence(__ATOMIC_ACQUIRE, "agent");
            asm volatile("s_waitcnt vmcnt(0)" ::: "memory");
        }
        asm volatile("s_waitcnt lgkmcnt(0)" ::: "memory"); __builtin_amdgcn_s_barrier(); asm volatile("" ::: "memory");
        if (tid < BM) {
            const unsigned* sp = (const unsigned*)(ssq_x + 4 * (size_t)(u.pm * BM + tid)); float s = 0.f;
#pragma unroll
            for (int q = 0; q < 4; ++q) s += __builtin_bit_cast(float, __hip_atomic_load(sp + q, __ATOMIC_RELAXED, __HIP_MEMORY_SCOPE_SYSTEM));
            rsc[tid] = __builtin_amdgcn_rsqf(s * (1.0f / DM) + EPS);
        }
        asm volatile("s_waitcnt lgkmcnt(0)" ::: "memory"); __builtin_amdgcn_s_barrier(); asm volatile("" ::: "memory");
        f32x4 gq[2][2];
#pragma unroll
        for (int bj = 0; bj < 2; ++bj) { gq[bj][0] = *(const f32x4*)(gain + col0 + bj * HALF); gq[bj][1] = *(const f32x4*)(gain + col0 + bj * HALF + 4); }
#pragma unroll
        for (int ai = 0; ai < 2; ++ai)
#pragma unroll
            for (int m = 0; m < 4; ++m) {
                const int rl = ai * HALF + wr * 64 + m * 16 + fr; const float ri = rsc[rl]; const size_t off = (size_t)(u.pm * BM + rl) * DM + col0;
#pragma unroll
                for (int bj = 0; bj < 2; ++bj) { *(f32x4*)(out + off + bj * HALF) = acc[ai][bj][m][0] * ri * gq[bj][0]; *(f32x4*)(out + off + bj * HALF + 4) = acc[ai][bj][m][1] * ri * gq[bj][1]; }
            }
    }
};
template <class Epi, class Sched, bool ALIGN_EPI = false, bool SP2 = false>
__device__ __forceinline__ void gemm_phase(PG8_LAS unsigned char* lds, const Gemm g, const Sched& S, const Epi& E) {
    int tid_ = threadIdx.x; asm volatile("" : "+v"(tid_));
    const int tid = tid_, wid = __builtin_amdgcn_readfirstlane(tid >> 6), lane = tid & 63, wr = wid >> 2, wc = wid & 3, fr = lane & 15, fq = lane >> 4;
    const int K = g.K, nt = K / BK;
    unsigned voffA[2], voffB[2];
#pragma unroll
    for (int i = 0; i < 2; ++i) { int R, C; stage_rc(tid * 16 + i * 8192, R, C); const int Rb = Epi::PERM ? ((R & ~31) + perm32(R & 31)) : R;
        voffA[i] = (unsigned)(R * K + C) * 2u; voffB[i] = (unsigned)(Rb * K + C) * 2u; }
    const size_t kstep = (size_t)(BK * 2);
    const size_t hstep = (size_t)HALF * K * 2;
    const size_t tstep = 2 * hstep;
    const unsigned ldsw = (unsigned)wid * 1024u;
    const int aoff = lds_byte(wr * 64 + fr, fq * 8), boff = lds_byte(wc * 32 + fr, fq * 8);
#define PG8_SA(b, h) (((b) * 2 + (h)) * HTB)
#define PG8_SB(b, h) ((4 + (b) * 2 + (h)) * HTB)
#define PG8_STAGE(bufoff, gbase, voff) do { _Pragma("unroll") for (int _i = 0; _i < 2; ++_i) \
        __builtin_amdgcn_global_load_lds((const unsigned*)((const char*)(gbase) + (voff)[_i]), (PG8_LAS unsigned*)(lds + (bufoff) + ldsw + _i * 8192), 16, 0, 0); } while (0)
#define PG8_LDA(dst, b, h) do { _Pragma("unroll") for (int m = 0; m < 4; ++m) _Pragma("unroll") for (int k = 0; k < 2; ++k) dst[m][k] = *(const PG8_LAS bf16x8*)(lds + PG8_SA(b, h) + aoff + m * 2048 + k * 1024); } while (0)
#define PG8_LDB(dst, b, h) do { _Pragma("unroll") for (int n = 0; n < 2; ++n) _Pragma("unroll") for (int k = 0; k < 2; ++k) dst[n][k] = *(const PG8_LAS bf16x8*)(lds + PG8_SB(b, h) + boff + n * 2048 + k * 1024); } while (0)
#define PG8_MMA(ai, bj, At, Bt) do { __builtin_amdgcn_s_setprio(1); _Pragma("unroll") for (int m = 0; m < 4; ++m) _Pragma("unroll") for (int n = 0; n < 2; ++n) _Pragma("unroll") for (int k = 0; k < 2; ++k) \
        acc[ai][bj][m][n] = __builtin_amdgcn_mfma_f32_16x16x32_bf16(Bt[n][k], At[m][k], acc[ai][bj][m][n], 0, 0, 0); __builtin_amdgcn_s_setprio(0); } while (0)
#define PG8_WAIT_V(n) asm volatile("s_waitcnt vmcnt(" #n ")" ::: "memory")
#define PG8_WAIT_L(n) asm volatile("s_waitcnt lgkmcnt(" #n ")" ::: "memory")
#define PG8_BAR __builtin_amdgcn_s_barrier()
#define PG8_SCHED __builtin_amdgcn_sched_barrier(0)
    Unit cur, nxt; int ui = 0;
    if (!S.next(0, cur)) return;
    f32x4 acc[2][2][4][2];
#pragma unroll
    for (int a = 0; a < 2; ++a)
#pragma unroll
        for (int b = 0; b < 2; ++b)
#pragma unroll
            for (int m = 0; m < 4; ++m)
#pragma unroll
                for (int n = 0; n < 2; ++n) acc[a][b][m][n] = (f32x4){0.f, 0.f, 0.f, 0.f};
    bf16x8 At[4][2], B0[2][2], B1[2][2];
    const char* cA = (const char*)g.A + (size_t)cur.pm * tstep; const char* cB = (const char*)g.Bt + (size_t)cur.pn * tstep;
    S.a_ready(cur);
    if constexpr (SP2) {
        PG8_STAGE(PG8_SB(0, 0), cB, voffB); PG8_STAGE(PG8_SB(0, 1), cB + hstep, voffB); PG8_STAGE(PG8_SA(0, 0), cA, voffA); PG8_STAGE(PG8_SA(0, 1), cA + hstep, voffA);
        if (wr == 1) PG8_BAR;
        PG8_WAIT_V(2); PG8_BAR;
        PG8_STAGE(PG8_SB(1, 0), cB + kstep, voffB); PG8_STAGE(PG8_SA(1, 0), cA + kstep, voffA); PG8_STAGE(PG8_SB(1, 1), cB + hstep + kstep, voffB);
        PG8_WAIT_V(6); PG8_BAR;
    } else {
        PG8_STAGE(PG8_SB(0, 0), cB, voffB); PG8_STAGE(PG8_SA(0, 0), cA, voffA); PG8_STAGE(PG8_SB(0, 1), cB + hstep, voffB); PG8_STAGE(PG8_SA(0, 1), cA + hstep, voffA);
        if (wr == 1) PG8_BAR;
        PG8_WAIT_V(4); PG8_BAR;
        PG8_STAGE(PG8_SB(1, 0), cB + kstep, voffB); PG8_STAGE(PG8_SA(1, 0), cA + kstep, voffA); PG8_STAGE(PG8_SB(1, 1), cB + hstep + kstep, voffB);
        PG8_WAIT_V(6); PG8_BAR;
    }
    for (;;) {
        const bool has_next = S.next(ui + 1, nxt);
        const char* nA = has_next ? (const char*)g.A + (size_t)nxt.pm * tstep : cA; const char* nB = has_next ? (const char*)g.Bt + (size_t)nxt.pn * tstep : cB;
        for (int t = 0; t < nt; t += 2) {
            const bool last = (t == nt - 2);
            const char* a1 = cA + (size_t)(t + 1) * kstep;
            const char* a2 = last ? nA : cA + (size_t)(t + 2) * kstep; const char* b2 = last ? nB : cB + (size_t)(t + 2) * kstep;
            const char* a3 = a2 + kstep; const char* b3 = b2 + kstep;
            if (last && has_next) S.a_ready(nxt);
            if constexpr (SP2) {
            PG8_LDB(B0, 0, 0); PG8_LDB(B1, 0, 1); PG8_SCHED; PG8_LDA(At, 0, 0); PG8_STAGE(PG8_SA(1, 1), a1 + hstep, voffA);
            PG8_WAIT_V(8); PG8_WAIT_L(0); PG8_BAR; PG8_MMA(0, 0, At, B0); PG8_MMA(0, 1, At, B1); PG8_BAR; PG8_SCHED;
            PG8_LDA(At, 0, 1); PG8_STAGE(PG8_SB(0, 0), b2, voffB); PG8_STAGE(PG8_SB(0, 1), b2 + hstep, voffB); PG8_STAGE(PG8_SA(0, 0), a2, voffA);
            PG8_WAIT_V(8); PG8_WAIT_L(0); PG8_BAR; PG8_MMA(1, 0, At, B0); PG8_MMA(1, 1, At, B1); PG8_BAR; PG8_SCHED;
            PG8_LDB(B0, 1, 0); PG8_LDB(B1, 1, 1); PG8_SCHED; PG8_LDA(At, 1, 0); PG8_STAGE(PG8_SA(0, 1), a2 + hstep, voffA);
            PG8_WAIT_V(8); PG8_WAIT_L(0); PG8_BAR; PG8_MMA(0, 0, At, B0); PG8_MMA(0, 1, At, B1); PG8_BAR; PG8_SCHED;
            PG8_LDA(At, 1, 1); PG8_STAGE(PG8_SB(1, 0), b3, voffB); PG8_STAGE(PG8_SB(1, 1), b3 + hstep, voffB); PG8_STAGE(PG8_SA(1, 0), a3, voffA);
            PG8_WAIT_V(8); PG8_WAIT_L(0); PG8_BAR; PG8_MMA(1, 0, At, B0); PG8_MMA(1, 1, At, B1); PG8_BAR; PG8_SCHED;
            } else {
            PG8_LDB(B0, 0, 0); PG8_SCHED; PG8_LDA(At, 0, 0); PG8_STAGE(PG8_SA(1, 1), a1 + hstep, voffA);
            PG8_WAIT_L(8); PG8_BAR; PG8_WAIT_L(0); PG8_MMA(0, 0, At, B0); PG8_BAR; PG8_SCHED;
            PG8_LDB(B1, 0, 1); PG8_STAGE(PG8_SB(0, 0), b2, voffB);
            PG8_BAR; PG8_WAIT_L(0); PG8_MMA(0, 1, At, B1); PG8_BAR;
            PG8_LDA(At, 0, 1); PG8_STAGE(PG8_SA(0, 0), a2, voffA);
            PG8_BAR; PG8_WAIT_L(0); PG8_MMA(1, 0, At, B0); PG8_BAR; PG8_SCHED;
            PG8_STAGE(PG8_SB(0, 1), b2 + hstep, voffB);
            PG8_WAIT_V(6); PG8_BAR; PG8_MMA(1, 1, At, B1); PG8_BAR;
            PG8_LDB(B0, 1, 0); PG8_SCHED; PG8_LDA(At, 1, 0); PG8_STAGE(PG8_SA(0, 1), a2 + hstep, voffA);
            PG8_WAIT_L(8); PG8_BAR; PG8_WAIT_L(0); PG8_MMA(0, 0, At, B0); PG8_BAR; PG8_SCHED;
            PG8_LDB(B1, 1, 1); PG8_STAGE(PG8_SB(1, 0), b3, voffB);
            PG8_BAR; PG8_WAIT_L(0); PG8_MMA(0, 1, At, B1); PG8_BAR;
            PG8_LDA(At, 1, 1); PG8_STAGE(PG8_SA(1, 0), a3, voffA);
            PG8_BAR; PG8_WAIT_L(0); PG8_MMA(1, 0, At, B0); PG8_BAR; PG8_SCHED;
            PG8_STAGE(PG8_SB(1, 1), b3 + hstep, voffB);
            PG8_WAIT_V(6); PG8_BAR; PG8_MMA(1, 1, At, B1); PG8_BAR;
            }
        }
        if constexpr (ALIGN_EPI) { if (wr == 0) PG8_BAR; }
        if constexpr (!Epi::AFTER_DRAIN) { E(acc, cur, wr, wc, fr, fq); S.done(cur); }
        if (!has_next) break;
#pragma unroll
        for (int a = 0; a < 2; ++a)
#pragma unroll
            for (int b = 0; b < 2; ++b)
#pragma unroll
                for (int m = 0; m < 4; ++m)
#pragma unroll
                    for (int n = 0; n < 2; ++n) acc[a][b][m][n] = (f32x4){0.f, 0.f, 0.f, 0.f};
        cur = nxt; cA = nA; cB = nB; ++ui;
        if constexpr (ALIGN_EPI) { if (wr == 1) PG8_BAR; }
    }
    PG8_WAIT_V(0);
    if constexpr (!ALIGN_EPI) { if (wr == 0) PG8_BAR; }
    PG8_BAR;
    if constexpr (Epi::AFTER_DRAIN) { E.fused(acc, cur, wr, wc, fr, fq, lds, wid, lane); S.done(cur); }
#undef PG8_SA
#undef PG8_SB
#undef PG8_STAGE
#undef PG8_LDA
#undef PG8_LDB
#undef PG8_MMA
#undef PG8_WAIT_V
#undef PG8_WAIT_L
#undef PG8_BAR
#undef PG8_SCHED
}
}
#define MFMA32(a, b, c) __builtin_amdgcn_mfma_f32_32x32x16_bf16((a), (b), (c), 0, 0, 0)
typedef __bf16 bf16x2v __attribute__((ext_vector_type(2)));
__device__ __forceinline__ unsigned cvt2(float lo, float hi) { f32x2 v = {lo, hi}; return __builtin_bit_cast(unsigned, __builtin_convertvector(v, bf16x2v)); }
#define DPP_ADD(a, ctrl) ((a) + __builtin_bit_cast(float, __builtin_amdgcn_mov_dpp(__builtin_bit_cast(int, (a)), (ctrl), 0xF, 0xF, true)))
__device__ __forceinline__ float row16_sum(float a) { a = DPP_ADD(a, 0xB1); a = DPP_ADD(a, 0x4E); a = DPP_ADD(a, 0x141); a = DPP_ADD(a, 0x140); return a; }
__device__ __forceinline__ int crow(int reg, int h) { return (reg & 3) + 8 * (reg >> 2) + 4 * h; }

constexpr int AT_KSTR = 72, AT_VSTR = 260, AT_K_BYTES = 256 * AT_KSTR * 2;
__device__ __forceinline__ void attn_item(LAS unsigned char* lds, const bf16_t* __restrict__ U, bf16_t* __restrict__ Y, const float* __restrict__ sinks, int item) {
    int tid_ = threadIdx.x; asm volatile("" : "+v"(tid_)); const int tid = tid_, lane = tid & 63, wid = tid >> 6, r = lane & 31, hh = lane >> 5;
    const int hk = item & 1, n = (item >> 1) & 31, b = item >> 6;
    LAS bf16_t* Ks = (LAS bf16_t*)lds; LAS bf16_t* Vt = (LAS bf16_t*)(lds + AT_K_BYTES);
    const long tok0 = (long)b * SEQ + 128 * (n - 1);
    for (int idx = tid; idx < 2048; idx += 512) {
        const int row = idx >> 3, ch = idx & 7;
        u32x4 kv = {0u, 0u, 0u, 0u}, vv = {0u, 0u, 0u, 0u};
        if (n > 0 || row >= 128) { const bf16_t* src = U + (size_t)(tok0 + row) * NIN + hk * 64 + ch * 8; kv = *(const u32x4*)(src + UC_K); vv = *(const u32x4*)(src + UC_V); }
        *(LAS u32x4*)(Ks + row * AT_KSTR + ch * 8) = kv;
#pragma unroll
        for (int e = 0; e < 8; ++e) Vt[(ch * 8 + e) * AT_VSTR + (row ^ (ch << 3))] = (bf16_t)(vv[e >> 1] >> (16 * (e & 1)));
    }
    LDS_BARRIER();
    const int g = wid >> 1, half = wid & 1, h = hk * 4 + g;
    const float slope = exp2f(-(float)(h + 1)), sink = sinks[h];
#pragma unroll 1
    for (int sub = 0; sub < 2; ++sub) {
        const int j = half * 2 + sub;
        const size_t qtok = (size_t)b * SEQ + 128 * n + 32 * j + r;
        bf16x8 qf[4];
#pragma unroll
        for (int s = 0; s < 4; ++s) qf[s] = *(const bf16x8*)(U + qtok * NIN + UC_Q + h * 64 + 16 * s + 8 * hh);
        f32x16 acc[5];
#pragma unroll
        for (int kt = 0; kt < 5; ++kt) {
#pragma unroll
            for (int i = 0; i < 16; ++i) acc[kt][i] = 0.f;
#pragma unroll
            for (int s = 0; s < 4; ++s) { const bf16x8 kf = *(const LAS bf16x8*)(Ks + (32 * (j + kt) + r) * AT_KSTR + 16 * s + 8 * hh); acc[kt] = MFMA32(kf, qf[s], acc[kt]); }
        }
        constexpr float L2E = 1.4426950408889634f;
        int rr = r; asm volatile("" : "+v"(rr));
        const int dq = rr - 4 * hh;
        const float sl2 = slope * L2E, sb = -sl2 * (float)(dq + 128), sink2 = sink * L2E;
        float mx = sink2;
#pragma unroll
        for (int kt = 0; kt < 5; ++kt) {
            const bool tile_ok = (n > 0) || (j + kt >= 4);
#pragma unroll
            for (int i = 0; i < 16; ++i) {
                const int c0 = 32 * kt + (i & 3) + 8 * (i >> 2), ci = (i & 3) + 8 * (i >> 2);
                float sc = fmaf(acc[kt][i], 0.125f * L2E, fmaf(sl2, (float)c0, sb));
                bool ok = tile_ok;
                if (kt == 0) ok = ok && (ci > dq);
                if (kt == 4) ok = ok && (ci <= dq);
                sc = ok ? sc : -INFINITY;
                acc[kt][i] = sc; mx = fmaxf(mx, sc);
            }
        }
        mx = fmaxf(mx, __shfl_xor(mx, 32));
        float sum = 0.f;
#pragma unroll
        for (int kt = 0; kt < 5; ++kt)
#pragma unroll
            for (int i = 0; i < 16; ++i) { const float p = __builtin_amdgcn_exp2f(acc[kt][i] - mx); acc[kt][i] = p; sum += p; }
        sum += __shfl_xor(sum, 32);
        const float inv = __builtin_amdgcn_rcpf(sum + __builtin_amdgcn_exp2f(sink2 - mx));
        f32x16 oacc[2];
#pragma unroll
        for (int dt = 0; dt < 2; ++dt)
#pragma unroll
            for (int i = 0; i < 16; ++i) oacc[dt][i] = 0.f;
#pragma unroll
        for (int kt = 0; kt < 5; ++kt)
#pragma unroll
            for (int s2 = 0; s2 < 2; ++s2) {
                u32x4 pw; pw.x = cvt2(acc[kt][8 * s2 + 0], acc[kt][8 * s2 + 1]); pw.y = cvt2(acc[kt][8 * s2 + 2], acc[kt][8 * s2 + 3]);
                pw.z = cvt2(acc[kt][8 * s2 + 4], acc[kt][8 * s2 + 5]); pw.w = cvt2(acc[kt][8 * s2 + 6], acc[kt][8 * s2 + 7]);
                const bf16x8 pf = __builtin_bit_cast(bf16x8, pw);
#pragma unroll
                for (int dt = 0; dt < 2; ++dt) {
                    const int vd = 32 * dt + r, vsw = ((vd >> 3) & 7) << 3, vk = 32 * (j + kt) + 16 * s2 + 4 * hh;
                    const s16x4 lo = *(const LAS s16x4*)(Vt + vd * AT_VSTR + (vk ^ vsw)), hi = *(const LAS s16x4*)(Vt + vd * AT_VSTR + ((vk + 8) ^ vsw));
                    const bf16x8 vf = __builtin_shufflevector(lo, hi, 0, 1, 2, 3, 4, 5, 6, 7);
                    oacc[dt] = MFMA32(vf, pf, oacc[dt]);
                }
            }
        bf16_t* yrow = Y + qtok * DM + YC_A + h * 64 + 4 * hh;
#pragma unroll
        for (int dt = 0; dt < 2; ++dt)
#pragma unroll
            for (int ig = 0; ig < 4; ++ig) {
                u32x2 w; w.x = cvt2(oacc[dt][4 * ig] * inv, oacc[dt][4 * ig + 1] * inv); w.y = cvt2(oacc[dt][4 * ig + 2] * inv, oacc[dt][4 * ig + 3] * inv);
                *(u32x2*)(yrow + 32 * dt + 8 * ig) = w;
            }
    }
    LDS_BARRIER();
}

constexpr int HST = 68, HARR = 64 * HST * 4;
constexpr int HB_ST = 72;
#define HSW(v) ((((v) >> 3) & 7) << 3)
struct HgIn { u32x4 fz, iv, qv; f32x4 s0, s1; };
__device__ __forceinline__ HgIn hg_load(const bf16_t* __restrict__ U, const float* __restrict__ HS, int item, int tid, bool full) {
    const int b = item >> 8, h = (item >> 6) & 3, c = item & 63, t = tid >> 3, k8 = (tid & 7) * 8;
    const bf16_t* src = U + ((size_t)b * SEQ + c * 64 + t) * NIN + h * 64 + k8;
    HgIn r; r.fz = *(const u32x4*)(src + UC_HF); r.iv = *(const u32x4*)(src + UC_HI);
    r.qv = *(const u32x4*)(src + UC_HQ); r.s0 = *(const f32x4*)(HS + (size_t)item * 4096 + tid * 8); r.s1 = *(const f32x4*)(HS + (size_t)item * 4096 + tid * 8 + 4);
    return r;
}
struct HgInA { u32x4 fz, iv; };
__device__ __forceinline__ HgInA hg_load_a(const bf16_t* __restrict__ U, int item, int tid) {
    const int b = item >> 8, h = (item >> 6) & 3, c = item & 63, t = tid >> 3, k8 = (tid & 7) * 8;
    const bf16_t* src = U + ((size_t)b * SEQ + c * 64 + t) * NIN + h * 64 + k8;
    HgInA r; r.fz = *(const u32x4*)(src + UC_HF); r.iv = *(const u32x4*)(src + UC_HI); return r;
}
__device__ __forceinline__ void hg_lb(const float* __restrict__ lb_logits, int layer, int h, int k8, float (&lb)[8]) {
#pragma unroll
    for (int e = 0; e < 8; ++e) { lb[e] = 0.f; if (layer == 1) { const float l0 = lb_logits[h * 64 + k8 + e], l1 = lb_logits[256 + h * 64 + k8 + e]; lb[e] = __builtin_amdgcn_rcpf(1.0f + __expf(l0 - l1)); } }
}
constexpr int HA_F = 0, HA_KK = HARR, HA_VT = 2 * HARR, HA_KD = HA_VT + 64 * HB_ST * 2, HA_SEG = HA_KD + 64 * HB_ST * 2;
__device__ __forceinline__ void hgrn_a_item(LAS unsigned char* lds, const HgInA& in, const float (&lbv)[8], int item, float* __restrict__ HS, float* __restrict__ HD) {
    int tid_ = threadIdx.x; asm volatile("" : "+v"(tid_)); const int tid = tid_, wid = tid >> 6, lane = tid & 63;
    LAS float* F = (LAS float*)(lds + HA_F); LAS float* KK = (LAS float*)(lds + HA_KK);
    LAS bf16_t* Vt = (LAS bf16_t*)(lds + HA_VT); LAS bf16_t* KdT = (LAS bf16_t*)(lds + HA_KD); LAS float* SEG = (LAS float*)(lds + HA_SEG);
    {
        const int t = tid >> 3, k8 = (tid & 7) * 8;
        const u32x4 fz = in.fz, iv = in.iv;
        float fo[8], ko[8];
#pragma unroll
        for (int e = 0; e < 8; ++e) {
            const float lb = lbv[e];
            const unsigned fw = fz[e >> 1], iw = iv[e >> 1];
            float z = (e & 1) ? bf_hi(fw) : bf_lo(fw); z = fminf(fmaxf(z, -80.f), 80.f);
            const float ez = __expf(-z), sg = __builtin_amdgcn_rcpf(1.0f + ez), sgn = ez * sg;
            fo[e] = lb + (1.0f - lb) * sg; ko[e] = (1.0f - lb) * sgn;
            Vt[(k8 + e) * HB_ST + (t ^ HSW(k8 + e))] = (bf16_t)((e & 1) ? (iw >> 16) : (iw & 0xffffu));
        }
        *(LAS f32x4*)(F + t * HST + k8) = (f32x4){fo[0], fo[1], fo[2], fo[3]}; *(LAS f32x4*)(F + t * HST + k8 + 4) = (f32x4){fo[4], fo[5], fo[6], fo[7]};
        *(LAS f32x4*)(KK + t * HST + k8) = (f32x4){ko[0], ko[1], ko[2], ko[3]}; *(LAS f32x4*)(KK + t * HST + k8 + 4) = (f32x4){ko[4], ko[5], ko[6], ko[7]};
    }
    LDS_BARRIER();
    {
        const int k = tid & 63, seg = tid >> 6; float fv[8], suf[8];
#pragma unroll
        for (int i = 0; i < 8; ++i) fv[i] = F[(8 * seg + i) * HST + k];
        suf[7] = 1.f;
#pragma unroll
        for (int i = 6; i >= 0; --i) suf[i] = suf[i + 1] * fv[i + 1];
        const float tot = suf[0] * fv[0];
        SEG[seg * 64 + k] = tot;
        LDS_BARRIER();
        float post = 1.f;
        for (int s2 = seg + 1; s2 < 8; ++s2) post *= SEG[s2 * 64 + k];
        float kd[8];
#pragma unroll
        for (int i = 0; i < 8; ++i) kd[i] = KK[(8 * seg + i) * HST + k] * suf[i] * post;
        u32x4 w; w.x = cvt2(kd[0], kd[1]); w.y = cvt2(kd[2], kd[3]); w.z = cvt2(kd[4], kd[5]); w.w = cvt2(kd[6], kd[7]);
        *(LAS u32x4*)(KdT + k * HB_ST + 8 * seg) = w;
        if (seg == 0) HD[item * 64 + k] = tot * post;
    }
    LDS_BARRIER();
    {
        const int tl = lane & 15, kq = lane >> 4, kt = wid >> 1, vt0 = 2 * (wid & 1);
        f32x4 a0 = {0.f, 0.f, 0.f, 0.f}, a1 = {0.f, 0.f, 0.f, 0.f};
#pragma unroll
        for (int ks = 0; ks < 2; ++ks) {
            const bf16x8 af = *(const LAS bf16x8*)(KdT + (16 * kt + tl) * HB_ST + 32 * ks + 8 * kq);
            const bf16x8 b0 = *(const LAS bf16x8*)(Vt + (16 * vt0 + tl) * HB_ST + ((32 * ks + 8 * kq) ^ HSW(16 * vt0 + tl))), b1 = *(const LAS bf16x8*)(Vt + (16 * (vt0 + 1) + tl) * HB_ST + ((32 * ks + 8 * kq) ^ HSW(16 * (vt0 + 1) + tl)));
            a0 = __builtin_amdgcn_mfma_f32_16x16x32_bf16(af, b0, a0, 0, 0, 0); a1 = __builtin_amdgcn_mfma_f32_16x16x32_bf16(af, b1, a1, 0, 0, 0);
        }
        float* hs = HS + (size_t)item * 4096 + (16 * kt + 4 * kq) * 64 + 16 * vt0 + tl;
#pragma unroll
        for (int i = 0; i < 4; ++i) { hs[i * 64] = a0[i]; hs[i * 64 + 16] = a1[i]; }
    }
    LDS_BARRIER();
}
constexpr int HC_F = 0, HC_KK = HARR, HC_Q = 2 * HARR, HC_BUF = 3 * HARR, HC_IMG = 64 * HB_ST * 2, HC_SET = 4 * HC_IMG, HC_QH = HC_BUF + 2 * HC_SET, HC_KB = HC_QH + HC_IMG, HC_SEG = HC_KB + HC_IMG;
__device__ __forceinline__ void hgc_out(LAS unsigned char* set, const bf16_t* __restrict__ U, int item, int tw, int lane, const float* __restrict__ gain, bf16_t* __restrict__ Y) {
    const LAS bf16_t* Vt = (const LAS bf16_t*)set; const LAS bf16_t* St = (const LAS bf16_t*)(set + HC_IMG); const LAS bf16_t* Qt = (const LAS bf16_t*)(set + 2 * HC_IMG); const LAS bf16_t* ATT = (const LAS bf16_t*)(set + 3 * HC_IMG);
    const int b = item >> 8, h = (item >> 6) & 3, c = item & 63;
    const size_t tok0 = (size_t)b * SEQ + c * 64;
    {
        const int tl = lane & 15, q4i = lane >> 4;
        f32x4 oa[4];
#pragma unroll
        for (int vt = 0; vt < 4; ++vt) oa[vt] = (f32x4){0.f, 0.f, 0.f, 0.f};
#pragma unroll
        for (int ks = 0; ks < 2; ++ks) {
            const bf16x8 b_att = *(const LAS bf16x8*)(ATT + (16 * tw + tl) * HB_ST + 32 * ks + 8 * q4i), b_q = *(const LAS bf16x8*)(Qt + (16 * tw + tl) * HB_ST + 32 * ks + 8 * q4i);
#pragma unroll
            for (int vt = 0; vt < 4; ++vt) {
                const bf16x8 a_v = *(const LAS bf16x8*)(Vt + (16 * vt + tl) * HB_ST + ((32 * ks + 8 * q4i) ^ HSW(16 * vt + tl))), a_s = *(const LAS bf16x8*)(St + (16 * vt + tl) * HB_ST + ((32 * ks + 8 * q4i) ^ HSW(16 * vt + tl)));
                oa[vt] = __builtin_amdgcn_mfma_f32_16x16x32_bf16(a_v, b_att, oa[vt], 0, 0, 0);
                oa[vt] = __builtin_amdgcn_mfma_f32_16x16x32_bf16(a_s, b_q, oa[vt], 0, 0, 0);
            }
        }
        float ss = 0.f;
#pragma unroll
        for (int vt = 0; vt < 4; ++vt) ss += (oa[vt][0] * oa[vt][0] + oa[vt][1] * oa[vt][1]) + (oa[vt][2] * oa[vt][2] + oa[vt][3] * oa[vt][3]);
        ss += __shfl_xor(ss, 16); ss += __shfl_xor(ss, 32);
        const float ri = __builtin_amdgcn_rsqf(ss * (1.0f / 64.0f) + EPS);
        const size_t tok = tok0 + 16 * tw + tl;
#pragma unroll
        for (int vt = 0; vt < 4; ++vt) {
            const int v0 = 16 * vt + 4 * q4i;
            const u32x2 gv = *(const u32x2*)(U + tok * NIN + UC_HG + h * 64 + v0);
            const f32x4 gn = *(const f32x4*)(gain + h * 64 + v0);
            const float y0 = oa[vt][0] * ri * gn[0] * siluf_(bf_lo(gv.x)), y1 = oa[vt][1] * ri * gn[1] * siluf_(bf_hi(gv.x));
            const float y2 = oa[vt][2] * ri * gn[2] * siluf_(bf_lo(gv.y)), y3 = oa[vt][3] * ri * gn[3] * siluf_(bf_hi(gv.y));
            u32x2 w; w.x = cvt2(y0, y1); w.y = cvt2(y2, y3);
            *(u32x2*)(Y + tok * DM + YC_B + h * 64 + v0) = w;
        }
    }
}
__device__ __forceinline__ void hgrn_c_item(LAS unsigned char* lds, const bf16_t* __restrict__ U, HgIn& in, const float* __restrict__ HS, int next_item, const float (&lbv)[8], int item, int prev_item, int par,
                                            const float* __restrict__ gain, bf16_t* __restrict__ Y) {
    int tid_ = threadIdx.x; asm volatile("" : "+v"(tid_)); const int tid = tid_, wid = tid >> 6, lane = tid & 63;
    LAS float* F = (LAS float*)(lds + HC_F); LAS float* KK = (LAS float*)(lds + HC_KK); LAS float* Q = (LAS float*)(lds + HC_Q);
    LAS unsigned char* set = lds + HC_BUF + par * HC_SET;
    LAS bf16_t* Vt = (LAS bf16_t*)set; LAS bf16_t* St = (LAS bf16_t*)(set + HC_IMG); LAS bf16_t* Qt = (LAS bf16_t*)(set + 2 * HC_IMG); LAS bf16_t* ATT = (LAS bf16_t*)(set + 3 * HC_IMG);
    LAS float* SEG = (LAS float*)(lds + HC_SEG);
    {
        const int t = tid >> 3, k8 = (tid & 7) * 8;
        const u32x4 fz = in.fz, iv = in.iv, qv = in.qv; const f32x4 s0 = in.s0, s1 = in.s1;
        for (int i = tid; i < 64 * HB_ST / 2; i += 512) ((LAS unsigned*)ATT)[i] = 0u;
        float fo[8], ko[8], qo[8];
#pragma unroll
        for (int e = 0; e < 8; ++e) {
            const float lb = lbv[e];
            const unsigned fw = fz[e >> 1], iw = iv[e >> 1], qw = qv[e >> 1];
            float z = (e & 1) ? bf_hi(fw) : bf_lo(fw); z = fminf(fmaxf(z, -80.f), 80.f);
            const float ez = __expf(-z), sg = __builtin_amdgcn_rcpf(1.0f + ez), sgn = ez * sg;
            fo[e] = lb + (1.0f - lb) * sg; ko[e] = (1.0f - lb) * sgn;
            const float q = (e & 1) ? bf_hi(qw) : bf_lo(qw); qo[e] = siluf_(q);
            Vt[(k8 + e) * HB_ST + (t ^ HSW(k8 + e))] = (bf16_t)((e & 1) ? (iw >> 16) : (iw & 0xffffu));
            const float sv = e < 4 ? s0[e] : s1[e - 4]; St[(k8 + e) * HB_ST + (t ^ HSW(k8 + e))] = (bf16_t)cvt2(sv, sv);
        }
        *(LAS f32x4*)(F + t * HST + k8) = (f32x4){fo[0], fo[1], fo[2], fo[3]}; *(LAS f32x4*)(F + t * HST + k8 + 4) = (f32x4){fo[4], fo[5], fo[6], fo[7]};
        *(LAS f32x4*)(KK + t * HST + k8) = (f32x4){ko[0], ko[1], ko[2], ko[3]}; *(LAS f32x4*)(KK + t * HST + k8 + 4) = (f32x4){ko[4], ko[5], ko[6], ko[7]};
        *(LAS f32x4*)(Q + t * HST + k8) = (f32x4){qo[0], qo[1], qo[2], qo[3]}; *(LAS f32x4*)(Q + t * HST + k8 + 4) = (f32x4){qo[4], qo[5], qo[6], qo[7]};
    }
    LDS_BARRIER();
    {
        LAS bf16_t* QH = (LAS bf16_t*)(lds + HC_QH); LAS bf16_t* KB = (LAS bf16_t*)(lds + HC_KB);
        const int k = tid & 63, seg = tid >> 6; float run = 1.f, pv[8], fv[8];
#pragma unroll
        for (int i = 0; i < 8; ++i) { fv[i] = F[(8 * seg + i) * HST + k]; run *= fv[i]; pv[i] = run; }
        SEG[seg * 64 + k] = run;
        LDS_BARRIER();
        float pre = 1.f;
        for (int s2 = 0; s2 < seg; ++s2) pre *= SEG[s2 * 64 + k];
        const float preb = (seg & 1) ? SEG[(seg - 1) * 64 + k] : 1.f, postb = (seg & 1) ? 1.f : SEG[(seg + 1) * 64 + k];
        float suf = 1.f;
#pragma unroll
        for (int i = 7; i >= 0; --i) { const int row = 8 * seg + i; const float qv_ = Q[row * HST + k];
            const float qp = qv_ * (pv[i] * pre), qh = qv_ * (pv[i] * preb), kb = KK[row * HST + k] * (suf * postb);
            Qt[row * HB_ST + k] = (bf16_t)cvt2(qp, qp); QH[row * HB_ST + k] = (bf16_t)cvt2(qh, qh); KB[row * HB_ST + k] = (bf16_t)cvt2(kb, kb); suf *= fv[i]; }
    }
    LDS_BARRIER();
    if (wid < 4) {
        const int base = 16 * wid, sa = (tid >> 3) & 7, kq = tid & 7, nA = 16 - sa, ra = base + sa, rb = base + 15 - sa;
        f32x4 w0 = *(const LAS f32x4*)(KK + ra * HST + 8 * kq), w1 = *(const LAS f32x4*)(KK + ra * HST + 8 * kq + 4);
        const f32x4 wB0 = *(const LAS f32x4*)(KK + rb * HST + 8 * kq), wB1 = *(const LAS f32x4*)(KK + rb * HST + 8 * kq + 4);
#define HGC_DOT() (((q0[0] * w0[0] + q0[1] * w0[1]) + (q0[2] * w0[2] + q0[3] * w0[3])) + ((q1[0] * w1[0] + q1[1] * w1[1]) + (q1[2] * w1[2] + q1[3] * w1[3])))
#define HGC_STORE(t_, s_) do { a = DPP_ADD(a, 0xB1); a = DPP_ADD(a, 0x4E); a = DPP_ADD(a, 0x141); if (kq == 0) ATT[(t_) * HB_ST + (s_)] = (bf16_t)cvt2(a, a); } while (0)
        {
            const f32x4 q0 = *(const LAS f32x4*)(Q + ra * HST + 8 * kq), q1 = *(const LAS f32x4*)(Q + ra * HST + 8 * kq + 4);
            float a = HGC_DOT(); HGC_STORE(ra, ra);
        }
#pragma unroll
        for (int j = 1; j < 9; ++j) {
            const int t = ra + j;
            const f32x4 f0 = *(const LAS f32x4*)(F + t * HST + 8 * kq), f1 = *(const LAS f32x4*)(F + t * HST + 8 * kq + 4);
            const f32x4 q0 = *(const LAS f32x4*)(Q + t * HST + 8 * kq), q1 = *(const LAS f32x4*)(Q + t * HST + 8 * kq + 4);
            w0 = w0 * f0; w1 = w1 * f1;
            float a = HGC_DOT(); HGC_STORE(t, ra);
        }
#pragma unroll
        for (int j = 9; j < 17; ++j) {
            const bool inA = j < nA; const int s = inA ? ra : rb; const int t = inA ? ra + j : rb + (j - nA);
            const f32x4 f0 = *(const LAS f32x4*)(F + t * HST + 8 * kq), f1 = *(const LAS f32x4*)(F + t * HST + 8 * kq + 4);
            const f32x4 q0 = *(const LAS f32x4*)(Q + t * HST + 8 * kq), q1 = *(const LAS f32x4*)(Q + t * HST + 8 * kq + 4);
            if (j == nA) { w0 = wB0; w1 = wB1; } else { w0 = w0 * f0; w1 = w1 * f1; }
            float a = HGC_DOT(); HGC_STORE(t, s);
        }
#undef HGC_DOT
#undef HGC_STORE
        {
            const LAS bf16_t* QH = (const LAS bf16_t*)(lds + HC_QH); const LAS bf16_t* KB = (const LAS bf16_t*)(lds + HC_KB);
            const int tl = lane & 15, q4i = lane >> 4;
            for (int ti = wid; ti < 6; ti += 4) {
                const int I = ti < 1 ? 1 : (ti < 3 ? 2 : 3), J = ti - (I * (I - 1)) / 2;
                f32x4 d = {0.f, 0.f, 0.f, 0.f};
#pragma unroll
                for (int ks = 0; ks < 2; ++ks) {
                    bf16x8 af = *(const LAS bf16x8*)(QH + (16 * I + tl) * HB_ST + 32 * ks + 8 * q4i);
                    const bf16x8 bfr = *(const LAS bf16x8*)(KB + (16 * J + tl) * HB_ST + 32 * ks + 8 * q4i);
                    if (I - J >= 2) {
                        const LAS float* sg = SEG + 32 * ks + 8 * q4i;
                        f32x4 g0 = *(const LAS f32x4*)(sg + (2 * (J + 1)) * 64) * *(const LAS f32x4*)(sg + (2 * (J + 1) + 1) * 64), g1 = *(const LAS f32x4*)(sg + (2 * (J + 1)) * 64 + 4) * *(const LAS f32x4*)(sg + (2 * (J + 1) + 1) * 64 + 4);
                        if (I - J == 3) { g0 = g0 * *(const LAS f32x4*)(sg + (2 * (J + 2)) * 64) * *(const LAS f32x4*)(sg + (2 * (J + 2) + 1) * 64); g1 = g1 * *(const LAS f32x4*)(sg + (2 * (J + 2)) * 64 + 4) * *(const LAS f32x4*)(sg + (2 * (J + 2) + 1) * 64 + 4); }
                        const u32x4 aw = __builtin_bit_cast(u32x4, af);
                        u32x4 o; o.x = cvt2(bf_lo(aw.x) * g0[0], bf_hi(aw.x) * g0[1]); o.y = cvt2(bf_lo(aw.y) * g0[2], bf_hi(aw.y) * g0[3]); o.z = cvt2(bf_lo(aw.z) * g1[0], bf_hi(aw.z) * g1[1]); o.w = cvt2(bf_lo(aw.w) * g1[2], bf_hi(aw.w) * g1[3]);
                        af = __builtin_bit_cast(bf16x8, o);
                    }
                    d = __builtin_amdgcn_mfma_f32_16x16x32_bf16(af, bfr, d, 0, 0, 0);
                }
#pragma unroll
                for (int i = 0; i < 4; ++i) ATT[(16 * I + 4 * q4i + i) * HB_ST + 16 * J + tl] = (bf16_t)cvt2(d[i], d[i]);
            }
        }
    }
    else {
        if (prev_item >= 0) hgc_out(lds + HC_BUF + (par ^ 1) * HC_SET, U, prev_item, wid - 4, lane, gain, Y);
    }
    if (next_item >= 0) in = hg_load(U, HS, next_item, tid, true);
    LDS_BARRIER();
}
__device__ __forceinline__ void hgrn_c_tail(LAS unsigned char* lds, const bf16_t* __restrict__ U, int prev_item, int par_prev, const float* __restrict__ gain, bf16_t* __restrict__ Y) {
    int tid_ = threadIdx.x; asm volatile("" : "+v"(tid_)); const int wid = tid_ >> 6, lane = tid_ & 63;
    if (wid >= 4 && prev_item >= 0) hgc_out(lds + HC_BUF + par_prev * HC_SET, U, prev_item, wid - 4, lane, gain, Y);
    LDS_BARRIER();
}

constexpr int S5_XST = 132, S5_XS_BYTES = 16 * S5_XST * 4, S5_ZB_OFF = 8 * S5_XS_BYTES, S5_ZST = 264;
#define MFMA16(a, b, c) __builtin_amdgcn_mfma_f32_16x16x32_bf16((a), (b), (c), 0, 0, 0)
__device__ __forceinline__ void s5_bu_tile(LAS float* BU, const bf16x8 af, const bf16x8 (&bfr)[8], int tl, int kq) {
#pragma unroll
    for (int ct = 0; ct < 8; ++ct) { const f32x4 d = MFMA16(af, bfr[ct], ((f32x4){0.f, 0.f, 0.f, 0.f}));
#pragma unroll
        for (int i = 0; i < 4; ++i) BU[(4 * kq + i) * S5_XST + 16 * ct + tl] = d[i]; }
}
__device__ __forceinline__ void s5_a_item(LAS unsigned char* lds, const bf16_t* __restrict__ U, const f32x4* __restrict__ SP, const bf16_t* __restrict__ BBh, int layer, int item, f32x2* __restrict__ SE) {
    int tid_ = threadIdx.x; asm volatile("" : "+v"(tid_)); const int tid = tid_, lane = tid & 63, wid = tid >> 6, tl = lane & 15, kq = lane >> 4;
    const size_t tok0 = (size_t)item * 64;
    LAS float* BU = (LAS float*)(lds + wid * S5_XS_BYTES);
    const bf16x8 zf = {0, 0, 0, 0, 0, 0, 0, 0};
#pragma unroll 1
    for (int gi = 0; gi < 2; ++gi) {
        const int g = wid + 8 * gi, lg = layer * 16 + g;
        const f32x4 sp = SP[lg * 64 + lane];
        bf16x8 bfr[8], af[4];
#pragma unroll
        for (int ct = 0; ct < 8; ++ct) bfr[ct] = kq < 2 ? *(const bf16x8*)(BBh + ((size_t)lg * 128 + 16 * ct + tl) * 16 + 8 * kq) : zf;
#pragma unroll
        for (int sc = 0; sc < 4; ++sc) af[sc] = kq < 2 ? *(const bf16x8*)(U + (tok0 + 16 * sc + tl) * NIN + UC_S5 + g * 16 + 8 * kq) : zf;
        float xr = 0.f, xi = 0.f;
#pragma unroll
        for (int sc = 0; sc < 4; ++sc) {
            s5_bu_tile(BU, af[sc], bfr, tl, kq);
            LDS_WAIT();
#pragma unroll
            for (int tt = 0; tt < 16; ++tt) { const f32x2 bu = *(const LAS f32x2*)(BU + tt * S5_XST + 2 * lane);
                const float nr = sp[0] * xr - sp[1] * xi + bu[0], ni = sp[0] * xi + sp[1] * xr + bu[1]; xr = nr; xi = ni; }
            LDS_WAIT();
        }
        SE[((size_t)item * 16 + g) * 64 + lane] = (f32x2){xr, xi};
    }
}
__device__ __forceinline__ void s5_c_item(LAS unsigned char* lds, const bf16_t* __restrict__ U, const f32x4* __restrict__ SP, const bf16_t* __restrict__ BBh, const bf16_t* __restrict__ CMh,
                                          const float* __restrict__ dsk, const bf16_t* __restrict__ WgT, const float* __restrict__ gbias, int layer, int item, const f32x2* __restrict__ SE, bf16_t* __restrict__ Y) {
    int tid_ = threadIdx.x; asm volatile("" : "+v"(tid_)); const int tid = tid_, lane = tid & 63, wid = tid >> 6, tl = lane & 15, kq = lane >> 4;
    const size_t tok0 = (size_t)item * 64;
    LAS float* XS = (LAS float*)(lds + wid * S5_XS_BYTES); LAS bf16_t* ZB = (LAS bf16_t*)(lds + S5_ZB_OFF);
    const bf16x8 zf = {0, 0, 0, 0, 0, 0, 0, 0};
    const int ch = tl;
#pragma unroll 1
    for (int gi = 0; gi < 2; ++gi) {
        const int g = wid + 8 * gi, lg = layer * 16 + g;
        const f32x4 sp = SP[lg * 64 + lane];
        bf16x8 bfr[8], af[4];
#pragma unroll
        for (int ct = 0; ct < 8; ++ct) bfr[ct] = kq < 2 ? *(const bf16x8*)(BBh + ((size_t)lg * 128 + 16 * ct + tl) * 16 + 8 * kq) : zf;
#pragma unroll
        for (int sc = 0; sc < 4; ++sc) af[sc] = kq < 2 ? *(const bf16x8*)(U + (tok0 + 16 * sc + tl) * NIN + UC_S5 + g * 16 + 8 * kq) : zf;
        bf16x8 cmf[4];
#pragma unroll
        for (int ks = 0; ks < 4; ++ks) cmf[ks] = *(const bf16x8*)(CMh + ((size_t)lg * 16 + ch) * 128 + 32 * ks + 8 * kq);
        float uq[16];
#pragma unroll
        for (int q = 0; q < 16; ++q) uq[q] = bf_lo((unsigned)U[(tok0 + 16 * (q >> 2) + 4 * kq + (q & 3)) * NIN + UC_S5 + g * 16 + ch]);
        const float dv = dsk[lg * 16 + ch];
        const f32x2 x0 = SE[((size_t)item * 16 + g) * 64 + lane];
        float xr = x0[0], xi = x0[1];
#pragma unroll
        for (int sc = 0; sc < 4; ++sc) {
            s5_bu_tile(XS, af[sc], bfr, tl, kq);
            LDS_WAIT();
#pragma unroll
            for (int tt = 0; tt < 16; ++tt) { LAS f32x2* xp = (LAS f32x2*)(XS + tt * S5_XST + 2 * lane); const f32x2 bu = *xp;
                const float nr = sp[0] * xr - sp[1] * xi + bu[0], ni = sp[0] * xi + sp[1] * xr + bu[1]; xr = nr; xi = ni; *xp = (f32x2){xr, xi}; }
            LDS_WAIT();
            f32x4 ya = {0.f, 0.f, 0.f, 0.f};
#pragma unroll
            for (int ks = 0; ks < 4; ++ks) { const f32x4 xa = *(const LAS f32x4*)(XS + tl * S5_XST + 32 * ks + 8 * kq), xb = *(const LAS f32x4*)(XS + tl * S5_XST + 32 * ks + 8 * kq + 4);
                u32x4 aw; aw.x = cvt2(xa[0], xa[1]); aw.y = cvt2(xa[2], xa[3]); aw.z = cvt2(xb[0], xb[1]); aw.w = cvt2(xb[2], xb[3]);
                ya = MFMA16(__builtin_bit_cast(bf16x8, aw), cmf[ks], ya); }
#pragma unroll
            for (int i = 0; i < 4; ++i) { const int t = 16 * sc + 4 * kq + i;
                { const float zv = gelu_tanh(ya[i] + dv * uq[4 * sc + i]); ZB[t * S5_ZST + g * 16 + ch] = (bf16_t)cvt2(zv, zv); } }
            LDS_WAIT();
        }
    }
    LDS_BARRIER();
    {
        const int r = lane & 31, hh = lane >> 5, n0 = 32 * wid;
        f32x16 ga[2];
#pragma unroll
        for (int mt = 0; mt < 2; ++mt)
#pragma unroll
            for (int i = 0; i < 16; ++i) ga[mt][i] = 0.f;
#pragma unroll 4
        for (int s = 0; s < 16; ++s) {
            const bf16x8 wfr = *(const bf16x8*)(WgT + (size_t)layer * 65536 + (n0 + r) * 256 + 16 * s + 8 * hh);
#pragma unroll
            for (int mt = 0; mt < 2; ++mt) { const bf16x8 zfr = *(const LAS bf16x8*)(ZB + (32 * mt + r) * S5_ZST + 16 * s + 8 * hh); ga[mt] = MFMA32(wfr, zfr, ga[mt]); }
        }
#pragma unroll
        for (int ig = 0; ig < 4; ++ig) {
            const int nn = n0 + 8 * ig + 4 * hh;
            const f32x4 bias = *(const f32x4*)(gbias + layer * 256 + nn);
#pragma unroll
            for (int mt = 0; mt < 2; ++mt) { const int t = 32 * mt + r;
                const u32x2 zw = *(const LAS u32x2*)(ZB + t * S5_ZST + nn);
                const float o0 = bf_lo(zw.x) * sigmoidf_(ga[mt][4 * ig] + bias[0]), o1 = bf_hi(zw.x) * sigmoidf_(ga[mt][4 * ig + 1] + bias[1]);
                const float o2 = bf_lo(zw.y) * sigmoidf_(ga[mt][4 * ig + 2] + bias[2]), o3 = bf_hi(zw.y) * sigmoidf_(ga[mt][4 * ig + 3] + bias[3]);
                u32x2 w; w.x = cvt2(o0, o1); w.y = cvt2(o2, o3);
                *(u32x2*)(Y + (tok0 + t) * DM + YC_C + nn) = w; }
        }
    }
    LDS_BARRIER();
}

#define XB_TMO      128
#define XB_XCNT(j)  (256  + 64 * (j))
#define XB_XSUB(j)  (1280 + 64 * (j))
#define XB_XGEN(j)  (2304 + 64 * (j))
#define XB_TOP      3328
#define XB_TOPGEN   3392
#define XCD_BAR_WORDS 3456
#define XB_SPIN_CAP (1u << 18)

__device__ __forceinline__ unsigned xb_ld(unsigned* p)              { return __hip_atomic_load(p, __ATOMIC_RELAXED, __HIP_MEMORY_SCOPE_AGENT); }
__device__ __forceinline__ unsigned xb_add(unsigned* p, unsigned v) { return __hip_atomic_fetch_add(p, v, __ATOMIC_RELAXED, __HIP_MEMORY_SCOPE_AGENT); }
__device__ __forceinline__ unsigned xb_xcc_id() { return (unsigned)__builtin_amdgcn_s_getreg((3 << 11) | 20) & 0xFu; }
#define XB_SPIN(cond, bar) do { unsigned _sp = 0; while (cond) { __builtin_amdgcn_s_sleep(1); \
    if ((++_sp & 255u) == 0u) { if (xb_ld(&(bar)[XB_TMO])) break; if (_sp > XB_SPIN_CAP) { atomicAdd(&(bar)[XB_TMO], 1u); break; } } } } while (0)

struct XcdBarrier {
    unsigned* bar; unsigned x;
    volatile LAS unsigned* st;
};

__device__ __forceinline__ XcdBarrier xcd_barrier_post(unsigned* bar, volatile LAS unsigned* st) {
    XcdBarrier b; b.bar = bar; b.x = xb_xcc_id(); b.st = st;
    if (threadIdx.x == 0) (void)xb_add(&bar[XB_XCNT(b.x)], 1u);
    return b;
}
__device__ __forceinline__ void xcd_barrier_complete(unsigned* bar, unsigned x, unsigned& nloc, unsigned& nx) {
    const unsigned G = gridDim.x * gridDim.y * gridDim.z;
    unsigned sum, cnt, mine, sp = 0u;
    for (;;) {
        sum = 0u; cnt = 0u; mine = 0u;
#pragma unroll
        for (unsigned j = 0; j < 16; ++j) { const unsigned c = xb_ld(&bar[XB_XCNT(j)]); sum += c; cnt += (c > 0u) ? 1u : 0u; mine = (j == x) ? c : mine; }
        if (sum == G) break;
        __builtin_amdgcn_s_sleep(1);
        if ((++sp & 255u) == 0u) { if (xb_ld(&bar[XB_TMO])) break; if (sp > XB_SPIN_CAP) { atomicAdd(&bar[XB_TMO], 1u); break; } }
    }
    nloc = mine > 0u ? mine : 1u; nx = cnt > 0u ? cnt : 1u;
}

__device__ __forceinline__ void xcd_barrier(const XcdBarrier& b) {
    asm volatile("s_waitcnt vmcnt(0)" ::: "memory");
    __syncthreads();
    if (threadIdx.x == 0) {
        unsigned* bar = b.bar;
        __builtin_amdgcn_s_waitcnt(0);
        unsigned nloc = b.st[0], nx = b.st[1];
        if (nloc == 0u) { xcd_barrier_complete(bar, b.x, nloc, nx); b.st[0] = nloc; b.st[1] = nx; }
        const unsigned old = xb_add(&bar[XB_XSUB(b.x)], 1u);
        const unsigned gen = old / nloc;
        if (old + 1u == (gen + 1u) * nloc) {
            __builtin_amdgcn_fence(__ATOMIC_RELEASE, "agent");
            asm volatile("s_waitcnt vmcnt(0)" ::: "memory");
            const unsigned og = xb_add(&bar[XB_TOP], 1u);
            const unsigned tg = og / nx;
            if (og + 1u == (tg + 1u) * nx) xb_add(&bar[XB_TOPGEN], 1u);
            else XB_SPIN(xb_ld(&bar[XB_TOPGEN]) == tg, bar);
            __builtin_amdgcn_fence(__ATOMIC_ACQUIRE, "agent");
            xb_add(&bar[XB_XGEN(b.x)], 1u);
            asm volatile("s_waitcnt vmcnt(0)" ::: "memory");
        } else {
            XB_SPIN(xb_ld(&bar[XB_XGEN(b.x)]) == gen, bar);
            __builtin_amdgcn_fence(__ATOMIC_ACQUIRE, "agent");
            asm volatile("s_waitcnt vmcnt(0)" ::: "memory");
        }
    }
    __syncthreads();
}
constexpr size_t MiB = 1u << 20;
constexpr size_t WL_GU1 = 0, WL_D1 = WL_GU1 + (size_t)NGU * DM * 2, WL_IN = WL_D1 + (size_t)DM * DFF * 2, WL_OUT = WL_IN + (size_t)NIN * DM * 2,
                 WL_GU2 = WL_OUT + (size_t)DM * DM * 2, WL_D2 = WL_GU2 + (size_t)NGU * DM * 2, WL_SIZE = WL_D2 + (size_t)DM * DFF * 2;
static_assert(WL_SIZE * 2 <= 90 * MiB, "weights");
constexpr size_t WS_W = 0;
constexpr size_t WS_WG = 90 * MiB;
constexpr size_t WS_SP = 91 * MiB;
constexpr size_t WS_BB = 92 * MiB;
constexpr size_t WS_CM = 92 * MiB + 512 * 1024;
constexpr size_t WS_SSQ = 93 * MiB;
constexpr size_t WS_HD = 94 * MiB;
constexpr size_t WS_SE = 95 * MiB;
constexpr size_t WS_CTL = 99 * MiB;
constexpr size_t WS_FX = 99 * MiB + 64 * 1024;
constexpr size_t WS_XB = 100 * MiB;
constexpr size_t WS_G1 = 164 * MiB;
constexpr size_t WS_Y = 340 * MiB;
constexpr size_t WS_HS = 404 * MiB;
constexpr size_t WS_END = 436 * MiB;

constexpr int LDS_BYTES = 147456;
constexpr int LDS_RING = 131072;

struct Args {
    const float* in[26]; float* out; unsigned char* ws; int ph_lo, ph_hi;
};

constexpr int LDS_RINV = LDS_RING + 4096 + 512;
constexpr int LDS_TAB = LDS_BYTES - 512;
__device__ __forceinline__ const float* inptr(LAS unsigned char* lds, int i) {
    const u32x2 v = *(const LAS u32x2*)(lds + LDS_TAB + 8 * i);
    const unsigned lo = __builtin_amdgcn_readfirstlane(v.x), hi = __builtin_amdgcn_readfirstlane(v.y);
    return (const float*)(((unsigned long long)hi << 32) | lo);
}
#define INP(i) inptr(lds, (i))
__device__ __forceinline__ void p0_transpose_item(const float* __restrict__ W, int K, int N, const float* __restrict__ gain, bf16_t* __restrict__ WT, int k0, int n0, int orow0, LAS float* scr, int lane) {
    const int kr = lane >> 4, n4 = 4 * (lane & 15);
    f32x4 v[16];
#pragma unroll
    for (int i = 0; i < 16; ++i) v[i] = __builtin_nontemporal_load((const f32x4*)(W + (size_t)(k0 + 4 * i + kr) * N + n0 + n4));
    const int c = lane & 7;
    f32x4 g0 = {1.f, 1.f, 1.f, 1.f}, g1 = {1.f, 1.f, 1.f, 1.f};
    if (gain) { g0 = *(const f32x4*)(gain + k0 + 8 * c); g1 = *(const f32x4*)(gain + k0 + 8 * c + 4); }
#pragma unroll
    for (int i = 0; i < 16; ++i) { LAS float* d = scr + (4 * i + kr) * 65 + n4; d[0] = v[i][0]; d[1] = v[i][1]; d[2] = v[i][2]; d[3] = v[i][3]; }
    LDS_WAIT();
#pragma unroll
    for (int j = 0; j < 8; ++j) { const int n = (lane >> 3) + 8 * j; const LAS float* s = scr + (8 * c) * 65 + n;
        u32x4 o; o.x = pk2(s[0 * 65] * g0[0], s[1 * 65] * g0[1]); o.y = pk2(s[2 * 65] * g0[2], s[3 * 65] * g0[3]); o.z = pk2(s[4 * 65] * g1[0], s[5 * 65] * g1[1]); o.w = pk2(s[6 * 65] * g1[2], s[7 * 65] * g1[3]);
        __builtin_nontemporal_store(o, (u32x4*)(WT + (size_t)(orow0 + n) * K + k0 + 8 * c)); }
    LDS_WAIT();
}
__device__ __forceinline__ float wave_sum(float v) {
#pragma unroll
    for (int o = 1; o < 64; o <<= 1) v += __shfl_xor(v, o);
    return v;
}
__device__ __forceinline__ int gu_row(int n0, int up) { return (n0 >> 7) * 256 + (n0 & 127) + up * 128; }

__device__ __forceinline__ void p0_prologue(LAS unsigned char* lds, unsigned char* ws) {
    const int tid = threadIdx.x, lane = tid & 63, wid = tid >> 6;
    LAS float* scr = (LAS float*)(lds + wid * 16640);
    const int gw = blockIdx.x * 8 + wid, NGW = gridDim.x * 8;
    constexpr int I_G = 16 * 44, I_D = 44 * 16, I_IN = 16 * 32, I_O = 16 * 16, I_L = 6 * I_G + I_IN + I_O;
    static_assert(I_G == I_D, "item counts");
    for (int it = gw; it < DEPTH * I_L; it += NGW) {
        const int layer = it / I_L; int r = it % I_L;
        bf16_t* wl = (bf16_t*)(ws + WS_W + (size_t)layer * WL_SIZE);
        const int seg = r < 6 * I_G ? r / I_G : (r < 6 * I_G + I_IN ? 6 : 7);
        if (seg < 6) { r -= seg * I_G;
            const int ffn = seg / 3, kind = seg % 3;
            if (kind < 2) { const int kb = r / 44, nb = r % 44; const float* W = INP((ffn ? 22 : 2) + kind) + (size_t)layer * DM * DFF; const float* gn = INP(ffn ? 21 : 1) + layer * DM;
                p0_transpose_item(W, DM, DFF, gn, (bf16_t*)((unsigned char*)wl + (ffn ? WL_GU2 : WL_GU1)), 64 * kb, 64 * nb, gu_row(64 * nb, kind), scr, lane); }
            else { const int kb = r / 16, nb = r % 16; const float* W = INP(ffn ? 24 : 4) + (size_t)layer * DFF * DM;
                p0_transpose_item(W, DFF, DM, nullptr, (bf16_t*)((unsigned char*)wl + (ffn ? WL_D2 : WL_D1)), 64 * kb, 64 * nb, 64 * nb, scr, lane); }
        } else if (seg == 6) { r -= 6 * I_G; const int kb = r / 32, nb = r % 32;
            p0_transpose_item(INP(6) + (size_t)layer * DM * NIN, DM, NIN, INP(5) + layer * DM, (bf16_t*)((unsigned char*)wl + WL_IN), 64 * kb, 64 * nb, 64 * nb, scr, lane);
        } else { r -= 6 * I_G + I_IN; const int kb = r / 16, nb = r % 16;
            p0_transpose_item(INP(20) + (size_t)layer * DM * DM, DM, DM, nullptr, (bf16_t*)((unsigned char*)wl + WL_OUT), 64 * kb, 64 * nb, 64 * nb, scr, lane); }
    }
    {
        const float* x = INP(0); bf16_t* XB = (bf16_t*)(ws + WS_XB); float* ssq = (float*)(ws + WS_SSQ);
        for (int m = 4 * gw; m < MTOK; m += 4 * NGW) {
            const f32x4* xr = (const f32x4*)(x + (size_t)m * DM) + lane; float sq[4] = {0.f, 0.f, 0.f, 0.f};
            u32x2* o8 = (u32x2*)(XB + (size_t)m * DM) + lane;
            f32x4 v[16];
#pragma unroll
            for (int j = 0; j < 16; ++j) v[j] = __builtin_nontemporal_load(xr + 64 * j);
#pragma unroll
            for (int j = 0; j < 16; ++j) { sq[j >> 2] += (v[j][0] * v[j][0] + v[j][1] * v[j][1]) + (v[j][2] * v[j][2] + v[j][3] * v[j][3]);
                u32x2 w; w.x = pk2(v[j][0], v[j][1]); w.y = pk2(v[j][2], v[j][3]); o8[64 * j] = w; }
#pragma unroll
            for (int q = 0; q < 4; ++q) sq[q] = wave_sum(sq[q]);
            if (lane < 16) ssq[4 * (size_t)m + lane] = (lane & 3) ? 0.f : (lane == 0 ? sq[0] : (lane == 4 ? sq[1] : (lane == 8 ? sq[2] : sq[3])));
        }
    }
    {
        const int gt = blockIdx.x * 512 + tid, NT = gridDim.x * 512;
        f32x4* SP = (f32x4*)(ws + WS_SP); bf16_t* BB = (bf16_t*)(ws + WS_BB); bf16_t* WgT = (bf16_t*)(ws + WS_WG);
        for (int e = gt; e < DEPTH * 16 * 64; e += NT) {
            const int lg = e >> 6;
            const float dt = expf(INP(12)[lg]), ar = INP(10)[e], ai = INP(11)[e];
            const float mag = expf(ar * dt), ang = ai * dt, abr = mag * cosf(ang), abi = mag * sinf(ang);
            float pr = abr, pi = abi;
#pragma unroll
            for (int q = 0; q < 6; ++q) { const float nr = pr * pr - pi * pi, ni = 2.f * pr * pi; pr = nr; pi = ni; }
            SP[e] = (f32x4){abr, abi, pr, pi};
            const float nr = abr - 1.0f, ni = abi, den = ar * ar + ai * ai, zr = (nr * ar + ni * ai) / den, zi = (ni * ar - nr * ai) / den;
#pragma unroll 4
            for (int c = 0; c < 16; ++c) { const float br = INP(13)[(size_t)e * 16 + c], bi = INP(14)[(size_t)e * 16 + c];
                BB[((size_t)e * 2 + 0) * 16 + c] = (bf16_t)f2bf(zr * br - zi * bi); BB[((size_t)e * 2 + 1) * 16 + c] = (bf16_t)f2bf(zr * bi + zi * br); }
        }
        {   bf16_t* CMh = (bf16_t*)(ws + WS_CM);
            for (int e = gt; e < DEPTH * 16 * 16 * 128; e += NT) { const int k = e & 127, ch = (e >> 7) & 15, lg = e >> 11, pp = k >> 1;
                const float v = (k & 1) ? -INP(16)[((size_t)lg * 16 + ch) * 64 + pp] : INP(15)[((size_t)lg * 16 + ch) * 64 + pp]; CMh[e] = (bf16_t)f2bf(v); } }
        for (int e = gt; e < DEPTH * 65536; e += NT) { const int layer = e >> 16, n = (e >> 8) & 255, k = e & 255; WgT[e] = (bf16_t)f2bf(INP(18)[(size_t)layer * 65536 + k * 256 + n]); }
    }
}

constexpr int N_PHASES = 1 + 9 * DEPTH + 1;
__global__ void __launch_bounds__(512, 2) fwd_kernel(Args A) {
    extern __shared__ __attribute__((aligned(16))) unsigned char lds_raw[];
    LAS unsigned char* lds = (LAS unsigned char*)lds_raw;
    cg::grid_group grid = cg::this_grid();
    const int lo = A.ph_lo, hi = A.ph_hi, G = gridDim.x, bid0 = blockIdx.x, tid = threadIdx.x;
    unsigned char* ws = A.ws;
    if (tid < 26) *(LAS u32x2*)(lds + LDS_TAB + 8 * tid) = __builtin_bit_cast(u32x2, A.in[tid]);
    if (tid < 2) *(LAS unsigned*)(lds + LDS_TAB + 256 + 4 * tid) = 0u;
    __syncthreads();
    const XcdBarrier bar = xcd_barrier_post((unsigned*)(ws + WS_CTL), (volatile LAS unsigned*)(lds + LDS_TAB + 256));
    bf16_t* XB = (bf16_t*)(ws + WS_XB); bf16_t* G1 = (bf16_t*)(ws + WS_G1); bf16_t* Ub = (bf16_t*)(ws + WS_G1); bf16_t* Yb = (bf16_t*)(ws + WS_Y);
    float* SSQ = (float*)(ws + WS_SSQ); float* HS = (float*)(ws + WS_HS); float* HD = (float*)(ws + WS_HD); f32x2* SE = (f32x2*)(ws + WS_SE);
    const f32x4* SP = (const f32x4*)(ws + WS_SP); const bf16_t* BB = (const bf16_t*)(ws + WS_BB); const bf16_t* WgT = (const bf16_t*)(ws + WS_WG);
    float* out = A.out;
#define IN(k) (lo <= (k) && (k) < hi)
#ifndef REP_SYNC
#define REP_SYNC 1
#endif
#define SEAM(k) do { if (IN(k) && IN((k) + 1)) { for (int rs_ = 0; rs_ < REP_SYNC; ++rs_) { if ((k) == 0) grid.sync(); else xcd_barrier(bar); } } } while (0)

#ifndef REP_HGC
#define REP_HGC 1
#endif
#ifndef REP_HGA
#define REP_HGA 1
#endif
#ifndef REP_S5A
#define REP_S5A 1
#endif
#ifndef REP_P0
#define REP_P0 1
#endif
#ifndef REP_MIXA
#define REP_MIXA 1
#endif
#ifndef REP_MIXC
#define REP_MIXC 1
#endif
#ifndef REP_GU
#define REP_GU 1
#endif
#ifndef REP_INP
#define REP_INP 1
#endif
    if (IN(0)) { for (int rep = 0; rep < REP_P0; ++rep) { p0_prologue(lds, ws); __syncthreads(); } }
    SEAM(0);
#pragma unroll 1
    for (int layer = 0; layer < DEPTH; ++layer) {
        const int pb = 1 + 9 * layer;
        int bid = bid0; asm volatile("" : "+s"(bid));
        const unsigned char* wl = ws + WS_W + (size_t)layer * WL_SIZE;
#pragma unroll 1
        for (int ffn = 0; ffn < 2; ++ffn) {
            const int p_gu = pb + (ffn ? 7 : 0), p_dn = p_gu + 1;
            if (IN(p_gu)) for (int rep = 0; rep < REP_GU; ++rep) {
#ifndef SKIP_GU
                pg8::Gemm g{XB, (const bf16_t*)(wl + (ffn ? WL_GU2 : WL_GU1)), MTOK, NGU, DM}; pg8::RinvOrder S; S.init(MTOK, NGU, G, bid); S.ssq = SSQ; S.tab = lds + LDS_RINV; S.par = 0;
                pg8::EpiSwiglu E{G1, lds + LDS_RINV, 0};
                pg8::gemm_phase<pg8::EpiSwiglu, pg8::RinvOrder, true, true>(lds, g, S, E);
#ifdef PROBE_GU5
                { pg8::Gemm g5{XB, (const bf16_t*)(wl + (ffn ? WL_GU2 : WL_GU1)), MTOK, 2560, DM}; pg8::RinvOrder S5o; S5o.init(MTOK, 2560, G, bid); S5o.ssq = SSQ; S5o.tab = lds + LDS_RINV; S5o.par = 0;
                  pg8::EpiSwiglu E5{G1, lds + LDS_RINV, 0};
                  pg8::gemm_phase<pg8::EpiSwiglu, pg8::RinvOrder, true, true>(lds, g5, S5o, E5); }
#endif
#endif
            }
            SEAM(p_gu);
            if (IN(p_dn)) {
#ifndef SKIP_DN
                pg8::Gemm g{G1, (const bf16_t*)(wl + (ffn ? WL_D2 : WL_D1)), MTOK, DM, DFF}; pg8::StaticOrder S; S.init(MTOK, DM, G, bid);
                if (layer == DEPTH - 1 && ffn == 1 && G == 256) {
                    pg8::EpiResidFinal E{out, out, INP(25), (float*)(ws + WS_FX), (unsigned*)(ws + WS_CTL) + 4096, 0.5f, (LAS float*)(lds + LDS_RING), (LAS float*)(lds + LDS_RINV)};
                    pg8::gemm_phase<pg8::EpiResidFinal, pg8::StaticOrder, true, true>(lds, g, S, E);
                } else {
                pg8::EpiResid E{(layer == 0 && ffn == 0) ? INP(0) : out, out, (layer == DEPTH - 1 && ffn == 1) ? nullptr : XB, SSQ, 0.5f, (LAS float*)(lds + LDS_RING)};
                pg8::gemm_phase<pg8::EpiResid, pg8::StaticOrder, true, true>(lds, g, S, E);
                }
#endif
            }
            SEAM(p_dn);
            if (ffn == 1) break;
            if (IN(pb + 2)) for (int rep = 0; rep < REP_INP; ++rep) {
#ifndef SKIP_INP
                pg8::Gemm g{XB, (const bf16_t*)(wl + WL_IN), MTOK, NIN, DM}; pg8::RinvOrder S; S.init(MTOK, NIN, G, bid); S.ssq = SSQ; S.tab = lds + LDS_RINV; S.par = 0;
                pg8::EpiScaleBf16 E{Ub, NIN, lds + LDS_RINV, 0};
                pg8::gemm_phase<pg8::EpiScaleBf16, pg8::RinvOrder, true, true>(lds, g, S, E);
#endif
            }
            SEAM(pb + 2);
            if (IN(pb + 3)) for (int rep = 0; rep < REP_MIXA; ++rep) {
#ifndef SKIP_ATTN
                for (int it = bid; it < 512; it += G) attn_item(lds, Ub, Yb, INP(7) + layer * 8, it);
#endif
#ifndef SKIP_HGA
                for (int r2 = 0; r2 < REP_HGA; ++r2) {
                    int tq = threadIdx.x; asm volatile("" : "+v"(tq));
                    float lb[8]; int hcur = (bid >> 6) & 3; hg_lb(INP(8), layer, hcur, (tq & 7) * 8, lb); HgInA cur = hg_load_a(Ub, bid < 2048 ? bid : 0, tq);
                    for (int it = bid; it < 2048; it += G) {
                        HgInA nxt = cur; if (it + G < 2048) nxt = hg_load_a(Ub, it + G, tq);
                        const int h = (it >> 6) & 3; if (h != hcur) { hg_lb(INP(8), layer, h, (tq & 7) * 8, lb); hcur = h; }
                        hgrn_a_item(lds, cur, lb, it, HS, HD); cur = nxt; }
                }
#endif
#ifndef SKIP_S5A
                for (int r2 = 0; r2 < REP_S5A; ++r2) for (int it = bid; it < 512; it += G) s5_a_item(lds, Ub, SP, BB, layer, it, SE);
#endif
                LDS_BARRIER();
            }
            SEAM(pb + 3);
            if (IN(pb + 4)) {
                int tid_s = threadIdx.x; asm volatile("" : "+v"(tid_s)); const int tid = tid_s;
                for (int e = bid * 512 + tid; e < 32 * 4096; e += G * 512) {
                    const int bh = e >> 12, kv = e & 4095, k = kv >> 6; float S = 0.f;
#pragma unroll 1
                    for (int c0 = 0; c0 < 64; c0 += 32) { float tv[32], dv[32];
#pragma unroll
                        for (int j = 0; j < 32; ++j) { const int item = bh * 64 + c0 + j; tv[j] = HS[(size_t)item * 4096 + kv]; dv[j] = HD[item * 64 + k]; }
#pragma unroll
                        for (int j = 0; j < 32; ++j) { const int item = bh * 64 + c0 + j; HS[(size_t)item * 4096 + kv] = S; S = dv[j] * S + tv[j]; } }
                }
                if (tid < 32) for (int e = bid * 32 + tid; e < 8 * 16 * 64; e += G * 32) {
                    const int b = e >> 10, gp = e & 1023; const f32x4 sp = SP[layer * 1024 + gp]; float xr = 0.f, xi = 0.f;
#pragma unroll 1
                    for (int c0 = 0; c0 < 64; c0 += 16) { f32x2 ev[16];
#pragma unroll
                        for (int j = 0; j < 16; ++j) ev[j] = SE[(size_t)(b * 64 + c0 + j) * 1024 + gp];
#pragma unroll
                        for (int j = 0; j < 16; ++j) { SE[(size_t)(b * 64 + c0 + j) * 1024 + gp] = (f32x2){xr, xi}; const float nr = sp[2] * xr - sp[3] * xi + ev[j][0], ni = sp[2] * xi + sp[3] * xr + ev[j][1]; xr = nr; xi = ni; } }
                }
            }
            SEAM(pb + 4);
            if (IN(pb + 5)) for (int rep = 0; rep < REP_MIXC; ++rep) {
#ifndef SKIP_HGC
                for (int r2 = 0; r2 < REP_HGC; ++r2) {
                    int tq = threadIdx.x; asm volatile("" : "+v"(tq));
                    float lb[8]; int hcur = (bid >> 6) & 3; hg_lb(INP(8), layer, hcur, (tq & 7) * 8, lb); HgIn cur = hg_load(Ub, HS, bid < 2048 ? bid : 0, tq, true);
                    int prev = -1, par = 0;
                    for (int it = bid; it < 2048; it += G) {
                        const int h = (it >> 6) & 3; if (h != hcur) { hg_lb(INP(8), layer, h, (tq & 7) * 8, lb); hcur = h; }
                        hgrn_c_item(lds, Ub, cur, HS, it + G < 2048 ? it + G : -1, lb, it, prev, par, INP(9) + layer * 256, Yb); prev = it; par ^= 1; }
                    hgrn_c_tail(lds, Ub, prev, par ^ 1, INP(9) + layer * 256, Yb);
                }
#endif
#ifndef SKIP_S5C
                for (int it = bid; it < 512; it += G) s5_c_item(lds, Ub, SP, BB, (const bf16_t*)(ws + WS_CM), INP(17), WgT, INP(19), layer, it, SE, Yb);
#endif
            }
            SEAM(pb + 5);
            if (IN(pb + 6)) {
#ifndef SKIP_OUT
                pg8::Gemm g{Yb, (const bf16_t*)(wl + WL_OUT), MTOK, DM, DM}; pg8::StaticOrder S; S.init(MTOK, DM, G, bid);
                pg8::EpiResid E{out, out, XB, SSQ, 1.0f, (LAS float*)(lds + LDS_RING)};
                pg8::gemm_phase<pg8::EpiResid, pg8::StaticOrder, true, true>(lds, g, S, E);
#endif
            }
            SEAM(pb + 6);
        }
    }
    if (IN(N_PHASES - 1) && G != 256) {
        const int bid = bid0; int tid_f = threadIdx.x; asm volatile("" : "+v"(tid_f));
        const int lane = tid_f & 63, gw = bid * 8 + (tid_f >> 6), NGW = G * 8; const float* gn = INP(25);
        f32x4 gv[4];
#pragma unroll
        for (int j = 0; j < 4; ++j) gv[j] = ((const f32x4*)gn)[lane + 64 * j];
        for (int m = gw; m < MTOK; m += NGW) {
            f32x4* xr = (f32x4*)(out + (size_t)m * DM) + lane; f32x4 v[4]; float s = 0.f;
#pragma unroll
            for (int j = 0; j < 4; ++j) { v[j] = xr[64 * j]; s += (v[j][0] * v[j][0] + v[j][1] * v[j][1]) + (v[j][2] * v[j][2] + v[j][3] * v[j][3]); }
            s = wave_sum(s); const float ri = 1.0f / sqrtf(s * (1.0f / DM) + EPS);
#pragma unroll
            for (int j = 0; j < 4; ++j) xr[64 * j] = v[j] * ri * gv[j];
        }
    }
#undef IN
#undef SEAM
}

#ifndef ONE_LAUNCH
#define ONE_LAUNCH 1
#endif
extern "C" void kernel_launch(void* const* d_in, const int* in_sizes, int n_in, void* d_out, int out_size, void* d_ws, size_t ws_size, hipStream_t stream) {
    static int grid = 0;
    if (grid == 0) {
        if (n_in != 26 || out_size != MTOK * DM || ws_size < WS_END) { fprintf(stderr, "kernel_launch: unexpected shapes (n_in %d out %d ws %zu)\n", n_in, out_size, ws_size); grid = -1; return; }
        int dev = 0, cus = 0, per_cu = 0;
        (void)hipGetDevice(&dev); (void)hipDeviceGetAttribute(&cus, hipDeviceAttributeMultiprocessorCount, dev);
        if (hipFuncSetAttribute((const void*)fwd_kernel, hipFuncAttributeMaxDynamicSharedMemorySize, LDS_BYTES) != hipSuccess) { fprintf(stderr, "kernel_launch: hipFuncSetAttribute failed\n"); grid = -1; return; }
        if (hipOccupancyMaxActiveBlocksPerMultiprocessor(&per_cu, (const void*)fwd_kernel, 512, LDS_BYTES) != hipSuccess || per_cu < 1) { fprintf(stderr, "kernel_launch: occupancy query says %d\n", per_cu); per_cu = 1; }
        (void)hipGetLastError();
        grid = cus * per_cu;
    }
    if (grid < 0) return;
    Args a{};
    for (int i = 0; i < 26; ++i) a.in[i] = (const float*)d_in[i];
    a.out = (float*)d_out; a.ws = (unsigned char*)d_ws;
    if (hipMemsetAsync((char*)d_ws + WS_CTL, 0, 64 * 1024, stream) != hipSuccess) { fprintf(stderr, "kernel_launch: memset failed\n"); return; }
#if ONE_LAUNCH
    a.ph_lo = 0; a.ph_hi = N_PHASES;
    void* args[] = {&a};
    hipError_t e = hipLaunchCooperativeKernel((const void*)fwd_kernel, dim3(grid), dim3(512), args, LDS_BYTES, stream);
    if (e != hipSuccess) fprintf(stderr, "cooperative launch failed: %s (grid %d)\n", hipGetErrorString(e), grid);
#else
    for (int p = 0; p < N_PHASES; ++p) { a.ph_lo = p; a.ph_hi = p + 1; hipLaunchKernelGGL(fwd_kernel, dim3(grid), dim3(512), LDS_BYTES, stream, a); }
#endif
}
```

```cpp
#include <hip/hip_runtime.h>
#include <hip/hip_cooperative_groups.h>
#include <cstdio>
#include <cstdint>
namespace cg = cooperative_groups;

constexpr int DM = 1024, BATCH = 8, SEQ = 4096, DEPTH = 2, MTOK = BATCH * SEQ;
constexpr int DFF = 2816, NGU = 2 * DFF, NIN = 2048;
constexpr float EPS = 1e-6f;
constexpr int UC_Q = 0, UC_K = 512, UC_V = 640, UC_HQ = 768, UC_HF = 1024, UC_HI = 1280, UC_HG = 1536, UC_S5 = 1792;
constexpr int YC_A = 0, YC_B = 512, YC_C = 768;

#define LAS __attribute__((address_space(3)))
typedef unsigned short bf16_t;
typedef short bf16x8 __attribute__((ext_vector_type(8)));
typedef short s16x4 __attribute__((ext_vector_type(4)));
typedef float f32x4 __attribute__((ext_vector_type(4)));
typedef float f32x2 __attribute__((ext_vector_type(2)));
typedef float f32x16 __attribute__((ext_vector_type(16)));
typedef unsigned u32x4 __attribute__((ext_vector_type(4)));
typedef unsigned u32x2 __attribute__((ext_vector_type(2)));

__device__ __forceinline__ unsigned f2bf(float f) { unsigned u = __builtin_bit_cast(unsigned, f); return (u + 0x7fffu + ((u >> 16) & 1u)) >> 16; }
__device__ __forceinline__ unsigned pk2(float lo, float hi) { return f2bf(lo) | (f2bf(hi) << 16); }
__device__ __forceinline__ float bf_lo(unsigned w) { return __builtin_bit_cast(float, w << 16); }
__device__ __forceinline__ float bf_hi(unsigned w) { return __builtin_bit_cast(float, w & 0xffff0000u); }
__device__ __forceinline__ float sigmoidf_(float x) { return __builtin_amdgcn_rcpf(1.0f + __expf(-x)); }
__device__ __forceinline__ float siluf_(float x) { return x * __builtin_amdgcn_rcpf(1.0f + __expf(-x)); }
__device__ __forceinline__ float gelu_tanh(float x) { const float u = 1.5957691216057308f * (x + 0.044715f * x * x * x); return x * __builtin_amdgcn_rcpf(1.0f + __expf(-u)); }
#define LDS_WAIT() asm volatile("s_waitcnt lgkmcnt(0)" ::: "memory")
#define LDS_BARRIER() do { asm volatile("s_waitcnt lgkmcnt(0)" ::: "memory"); __builtin_amdgcn_s_barrier(); asm volatile("" ::: "memory"); } while (0)

namespace pg8 {
#define PG8_LAS __attribute__((address_space(3)))
typedef unsigned short bf16_t;
typedef short bf16x8 __attribute__((ext_vector_type(8)));
typedef float f32x4 __attribute__((ext_vector_type(4)));
typedef unsigned u32x4 __attribute__((ext_vector_type(4)));
constexpr int BM = 256, BK = 64, HALF = 128, HTB = HALF * BK * 2  , STAGE_BYTES = 8 * HTB, NXCD = 8, WGM = 8;

__host__ __device__ __forceinline__ int lds_byte(int r, int c) { const int st = (r >> 4) * 2 + (c >> 5), rr = r & 15, cc = c & 31, ob = rr * 64 + cc * 2; return st * 1024 + (ob ^ (((ob >> 9) & 1) << 5)); }
__host__ __device__ __forceinline__ void stage_rc(int b, int& R, int& C) { const int st = b / 1024, sb = b % 1024, swz = sb ^ (((sb >> 9) & 1) << 5); R = (st >> 1) * 16 + swz / 64; C = (st & 1) * 32 + (swz % 64) / 2; }
__host__ __device__ __forceinline__ int perm32(int rho) { const int n = rho >> 4, i = rho & 15; return 8 * (i >> 2) + 4 * n + (i & 3); }

struct Unit { int pm, pn; };
struct Gemm { const bf16_t* A; const bf16_t* Bt; int M, N, K; };

struct StaticOrder {
    int nM, nN, nwg, G, c;
    __host__ __device__ void init(int M, int N, int G_, int c_) { nM = M / BM; nN = N / BM; nwg = nM * nN; G = G_; c = c_; }
    __host__ __device__ bool next(int i, Unit& u) const {
        const long L = (long)i * G + c; if (L >= nwg) return false;
        int wgid = (int)L; { const int q = nwg / NXCD, r = nwg % NXCD, xcd = wgid % NXCD, off = wgid / NXCD; wgid = (xcd < r ? xcd * (q + 1) : r * (q + 1) + (xcd - r) * q) + off; }
        const int nig = WGM * nN, gid = wgid / nig, fm = gid * WGM, gsz = (nM - fm) < WGM ? (nM - fm) : WGM;
        u.pm = fm + ((wgid % nig) % gsz); u.pn = (wgid % nig) / gsz; return true;
    }
    __device__ __forceinline__ void a_ready(const Unit&) const {}
    __device__ __forceinline__ void done(const Unit&) const {}
};

__device__ __forceinline__ unsigned cvt_pk_bf16(float lo, float hi) { unsigned r; asm volatile("v_cvt_pk_bf16_f32 %0, %1, %2" : "=v"(r) : "v"(lo), "v"(hi)); return r; }
__device__ __forceinline__ float row_rinv(const float* ssq, int row) {
    const f32x4 p = *(const f32x4*)(ssq + 4 * (size_t)row);
    return __builtin_amdgcn_rsqf(((p[0] + p[1]) + (p[2] + p[3])) * (1.0f / DM) + EPS);
}
constexpr int RINV_SLOT_BYTES = 4096;
struct RinvOrder : StaticOrder {
    const float* ssq; PG8_LAS unsigned char* tab; mutable int par;
    __device__ __forceinline__ void a_ready(const Unit& u) const {
        int t_ = threadIdx.x; asm volatile("" : "+v"(t_));
        const int wave = __builtin_amdgcn_readfirstlane(t_ >> 6), lane = t_ & 63;
        if (wave < 4) __builtin_amdgcn_global_load_lds((const unsigned*)(ssq + 4 * (size_t)(u.pm * BM + wave * 64 + lane)), (PG8_LAS unsigned*)(tab + par * RINV_SLOT_BYTES + wave * 1024), 16, 0, 0);
        par ^= 1;
    }
};
__device__ __forceinline__ float row_rinv_lds(const PG8_LAS unsigned char* slot, int rowlocal) {
    const f32x4 p = *(const PG8_LAS f32x4*)(slot + 16 * rowlocal);
    return __builtin_amdgcn_rsqf(((p[0] + p[1]) + (p[2] + p[3])) * (1.0f / DM) + EPS);
}
struct EpiSwiglu {
    static constexpr bool PERM = true, AFTER_DRAIN = false;
    bf16_t* O; PG8_LAS unsigned char* tab; mutable int par;
    __device__ __forceinline__ void operator()(const f32x4 (&acc)[2][2][4][2], const Unit& u, int wr, int wc, int fr, int fq) const {
        const int row0 = u.pm * BM + wr * 64 + fr, col0 = u.pn * HALF + wc * 32 + 8 * fq;
        const PG8_LAS unsigned char* slot = tab + par * RINV_SLOT_BYTES; par ^= 1;
        float rv[2][4];
#pragma unroll
        for (int ai = 0; ai < 2; ++ai)
#pragma unroll
            for (int m = 0; m < 4; ++m) rv[ai][m] = row_rinv_lds(slot, ai * HALF + wr * 64 + m * 16 + fr);
#pragma unroll
        for (int ai = 0; ai < 2; ++ai)
#pragma unroll
            for (int m = 0; m < 4; ++m) {
                const int row = row0 + ai * HALF + m * 16; const float ri = rv[ai][m];
                f32x4 h[2];
#pragma unroll
                for (int n = 0; n < 2; ++n)
#pragma unroll
                    for (int j = 0; j < 4; ++j) { const float g = acc[ai][0][m][n][j] * ri, up = acc[ai][1][m][n][j] * ri; h[n][j] = g * __builtin_amdgcn_rcpf(1.0f + __expf(-g)) * up; }
                u32x4 w; w.x = cvt_pk_bf16(h[0][0], h[0][1]); w.y = cvt_pk_bf16(h[0][2], h[0][3]); w.z = cvt_pk_bf16(h[1][0], h[1][1]); w.w = cvt_pk_bf16(h[1][2], h[1][3]);
                *(u32x4*)(O + (size_t)row * DFF + col0) = w;
            }
    }
};
struct EpiScaleBf16 {
    static constexpr bool PERM = true, AFTER_DRAIN = false;
    bf16_t* O; int ldc; PG8_LAS unsigned char* tab; mutable int par;
    __device__ __forceinline__ void operator()(const f32x4 (&acc)[2][2][4][2], const Unit& u, int wr, int wc, int fr, int fq) const {
        const int row0 = u.pm * BM + wr * 64 + fr, col0 = u.pn * BM + wc * 32 + 8 * fq;
        const PG8_LAS unsigned char* slot = tab + par * RINV_SLOT_BYTES; par ^= 1;
        float rv[2][4];
#pragma unroll
        for (int ai = 0; ai < 2; ++ai)
#pragma unroll
            for (int m = 0; m < 4; ++m) rv[ai][m] = row_rinv_lds(slot, ai * HALF + wr * 64 + m * 16 + fr);
#pragma unroll
        for (int ai = 0; ai < 2; ++ai)
#pragma unroll
            for (int m = 0; m < 4; ++m) {
                const int row = row0 + ai * HALF + m * 16; const float ri = rv[ai][m];
#pragma unroll
                for (int bj = 0; bj < 2; ++bj) { const f32x4 v0 = acc[ai][bj][m][0] * ri, v1 = acc[ai][bj][m][1] * ri;
                    u32x4 w; w.x = cvt_pk_bf16(v0[0], v0[1]); w.y = cvt_pk_bf16(v0[2], v0[3]); w.z = cvt_pk_bf16(v1[0], v1[1]); w.w = cvt_pk_bf16(v1[2], v1[3]);
                    *(u32x4*)(O + (size_t)row * ldc + col0 + bj * HALF) = w; }
            }
    }
};
struct EpiResid {
    static constexpr bool PERM = true, AFTER_DRAIN = false;
    const float* res; float* out; bf16_t* xb; float* ssq_out; float scale; PG8_LAS float* scr;
    __device__ __forceinline__ void operator()(const f32x4 (&acc)[2][2][4][2], const Unit& u, int wr, int wc, int fr, int fq) const {
        const int row0 = u.pm * BM + wr * 64 + fr, col0 = u.pn * BM + wc * 32 + 8 * fq;
#pragma unroll
        for (int ai = 0; ai < 2; ++ai)
#pragma unroll
            for (int m = 0; m < 4; ++m) {
                const int row = row0 + ai * HALF + m * 16; const size_t off = (size_t)row * DM + col0; float ss = 0.f;
#pragma unroll
                for (int bj = 0; bj < 2; ++bj) {
                    const f32x4 r0 = *(const f32x4*)(res + off + bj * HALF), r1 = *(const f32x4*)(res + off + bj * HALF + 4);
                    const f32x4 v0 = r0 + acc[ai][bj][m][0] * scale, v1 = r1 + acc[ai][bj][m][1] * scale;
                    *(f32x4*)(out + off + bj * HALF) = v0; *(f32x4*)(out + off + bj * HALF + 4) = v1;
                    ss += (v0[0] * v0[0] + v0[1] * v0[1]) + (v0[2] * v0[2] + v0[3] * v0[3]) + (v1[0] * v1[0] + v1[1] * v1[1]) + (v1[2] * v1[2] + v1[3] * v1[3]);
                    u32x4 w; w.x = cvt_pk_bf16(v0[0], v0[1]); w.y = cvt_pk_bf16(v0[2], v0[3]); w.z = cvt_pk_bf16(v1[0], v1[1]); w.w = cvt_pk_bf16(v1[2], v1[3]);
                    if (xb) *(u32x4*)(xb + off + bj * HALF) = w; }
                ss += __shfl_xor(ss, 16); ss += __shfl_xor(ss, 32);
                if (fq == 0) scr[(ai * HALF + wr * 64 + m * 16 + fr) * 4 + wc] = ss;
            }
        asm volatile("s_waitcnt lgkmcnt(0)" ::: "memory"); __builtin_amdgcn_s_barrier(); asm volatile("" ::: "memory");
        const int tid = threadIdx.x;
        if (tid < BM) { const f32x4 p = *(const PG8_LAS f32x4*)(scr + tid * 4); ssq_out[4 * (size_t)(u.pm * BM + tid) + u.pn] = (p[0] + p[1]) + (p[2] + p[3]); }
    }
};


struct EpiResidFinal {
    static constexpr bool PERM = true, AFTER_DRAIN = false;
    const float* res; float* out; const float* gain; float* ssq_x; unsigned* cnt; float scale; PG8_LAS float* scr; PG8_LAS float* rsc;
    __device__ __forceinline__ void operator()(f32x4 (&acc)[2][2][4][2], const Unit& u, int wr, int wc, int fr, int fq) const {
        const int row0 = u.pm * BM + wr * 64 + fr, col0 = u.pn * BM + wc * 32 + 8 * fq;
#pragma unroll
        for (int ai = 0; ai < 2; ++ai)
#pragma unroll
            for (int m = 0; m < 4; ++m) {
                const int row = row0 + ai * HALF + m * 16; const size_t off = (size_t)row * DM + col0; float ss = 0.f;
#pragma unroll
                for (int bj = 0; bj < 2; ++bj) {
                    const f32x4 r0 = *(const f32x4*)(res + off + bj * HALF), r1 = *(const f32x4*)(res + off + bj * HALF + 4);
                    const f32x4 v0 = r0 + acc[ai][bj][m][0] * scale, v1 = r1 + acc[ai][bj][m][1] * scale;
                    acc[ai][bj][m][0] = v0; acc[ai][bj][m][1] = v1;
                    ss += (v0[0] * v0[0] + v0[1] * v0[1]) + (v0[2] * v0[2] + v0[3] * v0[3]) + (v1[0] * v1[0] + v1[1] * v1[1]) + (v1[2] * v1[2] + v1[3] * v1[3]); }
                ss += __shfl_xor(ss, 16); ss += __shfl_xor(ss, 32);
                if (fq == 0) scr[(ai * HALF + wr * 64 + m * 16 + fr) * 4 + wc] = ss;
            }
        asm volatile("s_waitcnt lgkmcnt(0)" ::: "memory"); __builtin_amdgcn_s_barrier(); asm volatile("" ::: "memory");
        int t_ = threadIdx.x; asm volatile("" : "+v"(t_)); const int tid = t_, lane = tid & 63;
        unsigned* pc = cnt + 64 * u.pm;
        if (tid < BM) {
            const f32x4 p = *(const PG8_LAS f32x4*)(scr + tid * 4);
            __hip_atomic_store(ssq_x + 4 * (size_t)(u.pm * BM + tid) + u.pn, (p[0] + p[1]) + (p[2] + p[3]), __ATOMIC_RELAXED, __HIP_MEMORY_SCOPE_AGENT);
            asm volatile("s_waitcnt vmcnt(0)" ::: "memory");
            if (lane == 0) __hip_atomic_fetch_add(pc, 1u, __ATOMIC_RELEASE, __HIP_MEMORY_SCOPE_AGENT);
        }
        if (tid == 0) {
            unsigned spins = 0;
            while (__hip_atomic_load(pc, __ATOMIC_RELAXED, __HIP_MEMORY_SCOPE_AGENT) < 16u && ++spins < (1u << 22)) __builtin_amdgcn_s_sleep(2);
            __builtin_amdgcn_fence(__ATOMIC_ACQUIRE, "agent");
            asm volatile("s_waitcnt vmcnt(0)" ::: "memory");
        }
        asm volatile("s_waitcnt lgkmcnt(0)" ::: "memory"); __builtin_amdgcn_s_barrier(); asm volatile("" ::: "memory");
        if (tid < BM) {
            const unsigned* sp = (const unsigned*)(ssq_x + 4 * (size_t)(u.pm * BM + tid)); float s = 0.f;
#pragma unroll
            for (int q = 0; q < 4; ++q) s += __builtin_bit_cast(float, __hip_atomic_load(sp + q, __ATOMIC_RELAXED, __HIP_MEMORY_SCOPE_SYSTEM));
            rsc[tid] = __builtin_amdgcn_rsqf(s * (1.0f / DM) + EPS);
        }
        asm volatile("s_waitcnt lgkmcnt(0)" ::: "memory"); __builtin_amdgcn_s_barrier(); asm volatile("" ::: "memory");
        f32x4 gq[2][2];
#pragma unroll
        for (int bj = 0; bj < 2; ++bj) { gq[bj][0] = *(const f32x4*)(gain + col0 + bj * HALF); gq[bj][1] = *(const f32x4*)(gain + col0 + bj * HALF + 4); }
#pragma unroll
        for (int ai = 0; ai < 2; ++ai)
#pragma unroll
            for (int m = 0; m < 4; ++m) {
                const int rl = ai * HALF + wr * 64 + m * 16 + fr; const float ri = rsc[rl]; const size_t off = (size_t)(u.pm * BM + rl) * DM + col0;
#pragma unroll
                for (int bj = 0; bj < 2; ++bj) { *(f32x4*)(out + off + bj * HALF) = acc[ai][bj][m][0] * ri * gq[bj][0]; *(f32x4*)(out + off + bj * HALF + 4) = acc[ai][bj][m][1] * ri * gq[bj][1]; }
            }
    }
};
template <class Epi, class Sched, bool ALIGN_EPI = false, bool SP2 = false>
__device__ __forceinline__ void gemm_phase(PG8_LAS unsigned char* lds, const Gemm g, const Sched& S, const Epi& E) {
    int tid_ = threadIdx.x; asm volatile("" : "+v"(tid_));
    const int tid = tid_, wid = __builtin_amdgcn_readfirstlane(tid >> 6), lane = tid & 63, wr = wid >> 2, wc = wid & 3, fr = lane & 15, fq = lane >> 4;
    const int K = g.K, nt = K / BK;
    unsigned voffA[2], voffB[2];
#pragma unroll
    for (int i = 0; i < 2; ++i) { int R, C; stage_rc(tid * 16 + i * 8192, R, C); const int Rb = Epi::PERM ? ((R & ~31) + perm32(R & 31)) : R;
        voffA[i] = (unsigned)(R * K + C) * 2u; voffB[i] = (unsigned)(Rb * K + C) * 2u; }
    const size_t kstep = (size_t)(BK * 2);
    const size_t hstep = (size_t)HALF * K * 2;
    const size_t tstep = 2 * hstep;
    const unsigned ldsw = (unsigned)wid * 1024u;
    const int aoff = lds_byte(wr * 64 + fr, fq * 8), boff = lds_byte(wc * 32 + fr, fq * 8);
#define PG8_SA(b, h) (((b) * 2 + (h)) * HTB)
#define PG8_SB(b, h) ((4 + (b) * 2 + (h)) * HTB)
#define PG8_STAGE(bufoff, gbase, voff) do { _Pragma("unroll") for (int _i = 0; _i < 2; ++_i) \
        __builtin_amdgcn_global_load_lds((const unsigned*)((const char*)(gbase) + (voff)[_i]), (PG8_LAS unsigned*)(lds + (bufoff) + ldsw + _i * 8192), 16, 0, 0); } while (0)
#define PG8_LDA(dst, b, h) do { _Pragma("unroll") for (int m = 0; m < 4; ++m) _Pragma("unroll") for (int k = 0; k < 2; ++k) dst[m][k] = *(const PG8_LAS bf16x8*)(lds + PG8_SA(b, h) + aoff + m * 2048 + k * 1024); } while (0)
#define PG8_LDB(dst, b, h) do { _Pragma("unroll") for (int n = 0; n < 2; ++n) _Pragma("unroll") for (int k = 0; k < 2; ++k) dst[n][k] = *(const PG8_LAS bf16x8*)(lds + PG8_SB(b, h) + boff + n * 2048 + k * 1024); } while (0)
#define PG8_MMA(ai, bj, At, Bt) do { __builtin_amdgcn_s_setprio(1); _Pragma("unroll") for (int m = 0; m < 4; ++m) _Pragma("unroll") for (int n = 0; n < 2; ++n) _Pragma("unroll") for (int k = 0; k < 2; ++k) \
        acc[ai][bj][m][n] = __builtin_amdgcn_mfma_f32_16x16x32_bf16(Bt[n][k], At[m][k], acc[ai][bj][m][n], 0, 0, 0); __builtin_amdgcn_s_setprio(0); } while (0)
#define PG8_WAIT_V(n) asm volatile("s_waitcnt vmcnt(" #n ")" ::: "memory")
#define PG8_WAIT_L(n) asm volatile("s_waitcnt lgkmcnt(" #n ")" ::: "memory")
#define PG8_BAR __builtin_amdgcn_s_barrier()
#define PG8_SCHED __builtin_amdgcn_sched_barrier(0)
    Unit cur, nxt; int ui = 0;
    if (!S.next(0, cur)) return;
    f32x4 acc[2][2][4][2];
#pragma unroll
    for (int a = 0; a < 2; ++a)
#pragma unroll
        for (int b = 0; b < 2; ++b)
#pragma unroll
            for (int m = 0; m < 4; ++m)
#pragma unroll
                for (int n = 0; n < 2; ++n) acc[a][b][m][n] = (f32x4){0.f, 0.f, 0.f, 0.f};
    bf16x8 At[4][2], B0[2][2], B1[2][2];
    const char* cA = (const char*)g.A + (size_t)cur.pm * tstep; const char* cB = (const char*)g.Bt + (size_t)cur.pn * tstep;
    S.a_ready(cur);
    if constexpr (SP2) {
        PG8_STAGE(PG8_SB(0, 0), cB, voffB); PG8_STAGE(PG8_SB(0, 1), cB + hstep, voffB); PG8_STAGE(PG8_SA(0, 0), cA, voffA); PG8_STAGE(PG8_SA(0, 1), cA + hstep, voffA);
        if (wr == 1) PG8_BAR;
        PG8_WAIT_V(2); PG8_BAR;
        PG8_STAGE(PG8_SB(1, 0), cB + kstep, voffB); PG8_STAGE(PG8_SA(1, 0), cA + kstep, voffA); PG8_STAGE(PG8_SB(1, 1), cB + hstep + kstep, voffB);
        PG8_WAIT_V(6); PG8_BAR;
    } else {
        PG8_STAGE(PG8_SB(0, 0), cB, voffB); PG8_STAGE(PG8_SA(0, 0), cA, voffA); PG8_STAGE(PG8_SB(0, 1), cB + hstep, voffB); PG8_STAGE(PG8_SA(0, 1), cA + hstep, voffA);
        if (wr == 1) PG8_BAR;
        PG8_WAIT_V(4); PG8_BAR;
        PG8_STAGE(PG8_SB(1, 0), cB + kstep, voffB); PG8_STAGE(PG8_SA(1, 0), cA + kstep, voffA); PG8_STAGE(PG8_SB(1, 1), cB + hstep + kstep, voffB);
        PG8_WAIT_V(6); PG8_BAR;
    }
    for (;;) {
        const bool has_next = S.next(ui + 1, nxt);
        const char* nA = has_next ? (const char*)g.A + (size_t)nxt.pm * tstep : cA; const char* nB = has_next ? (const char*)g.Bt + (size_t)nxt.pn * tstep : cB;
        for (int t = 0; t < nt; t += 2) {
            const bool last = (t == nt - 2);
            const char* a1 = cA + (size_t)(t + 1) * kstep;
            const char* a2 = last ? nA : cA + (size_t)(t + 2) * kstep; const char* b2 = last ? nB : cB + (size_t)(t + 2) * kstep;
            const char* a3 = a2 + kstep; const char* b3 = b2 + kstep;
            if (last && has_next) S.a_ready(nxt);
            if constexpr (SP2) {
            PG8_LDB(B0, 0, 0); PG8_LDB(B1, 0, 1); PG8_SCHED; PG8_LDA(At, 0, 0); PG8_STAGE(PG8_SA(1, 1), a1 + hstep, voffA);
            PG8_WAIT_V(8); PG8_WAIT_L(0); PG8_BAR; PG8_MMA(0, 0, At, B0); PG8_MMA(0, 1, At, B1); PG8_BAR; PG8_SCHED;
            PG8_LDA(At, 0, 1); PG8_STAGE(PG8_SB(0, 0), b2, voffB); PG8_STAGE(PG8_SB(0, 1), b2 + hstep, voffB); PG8_STAGE(PG8_SA(0, 0), a2, voffA);
            PG8_WAIT_V(8); PG8_WAIT_L(0); PG8_BAR; PG8_MMA(1, 0, At, B0); PG8_MMA(1, 1, At, B1); PG8_BAR; PG8_SCHED;
            PG8_LDB(B0, 1, 0); PG8_LDB(B1, 1, 1); PG8_SCHED; PG8_LDA(At, 1, 0); PG8_STAGE(PG8_SA(0, 1), a2 + hstep, voffA);
            PG8_WAIT_V(8); PG8_WAIT_L(0); PG8_BAR; PG8_MMA(0, 0, At, B0); PG8_MMA(0, 1, At, B1); PG8_BAR; PG8_SCHED;
            PG8_LDA(At, 1, 1); PG8_STAGE(PG8_SB(1, 0), b3, voffB); PG8_STAGE(PG8_SB(1, 1), b3 + hstep, voffB); PG8_STAGE(PG8_SA(1, 0), a3, voffA);
            PG8_WAIT_V(8); PG8_WAIT_L(0); PG8_BAR; PG8_MMA(1, 0, At, B0); PG8_MMA(1, 1, At, B1); PG8_BAR; PG8_SCHED;
            } else {
            PG8_LDB(B0, 0, 0); PG8_SCHED; PG8_LDA(At, 0, 0); PG8_STAGE(PG8_SA(1, 1), a1 + hstep, voffA);
            PG8_WAIT_L(8); PG8_BAR; PG8_WAIT_L(0); PG8_MMA(0, 0, At, B0); PG8_BAR; PG8_SCHED;
            PG8_LDB(B1, 0, 1); PG8_STAGE(PG8_SB(0, 0), b2, voffB);
            PG8_BAR; PG8_WAIT_L(0); PG8_MMA(0, 1, At, B1); PG8_BAR;
            PG8_LDA(At, 0, 1); PG8_STAGE(PG8_SA(0, 0), a2, voffA);
            PG8_BAR; PG8_WAIT_L(0); PG8_MMA(1, 0, At, B0); PG8_BAR; PG8_SCHED;
            PG8_STAGE(PG8_SB(0, 1), b2 + hstep, voffB);
            PG8_WAIT_V(6); PG8_BAR; PG8_MMA(1, 1, At, B1); PG8_BAR;
            PG8_LDB(B0, 1, 0); PG8_SCHED; PG8_LDA(At, 1, 0); PG8_STAGE(PG8_SA(0, 1), a2 + hstep, voffA);
            PG8_WAIT_L(8); PG8_BAR; PG8_WAIT_L(0); PG8_MMA(0, 0, At, B0); PG8_BAR; PG8_SCHED;
            PG8_LDB(B1, 1, 1); PG8_STAGE(PG8_SB(1, 0), b3, voffB);
            PG8_BAR; PG8_WAIT_L(0); PG8_MMA(0, 1, At, B1); PG8_BAR;
            PG8_LDA(At, 1, 1); PG8_STAGE(PG8_SA(1, 0), a3, voffA);
            PG8_BAR; PG8_WAIT_L(0); PG8_MMA(1, 0, At, B0); PG8_BAR; PG8_SCHED;
            PG8_STAGE(PG8_SB(1, 1), b3 + hstep, voffB);
            PG8_WAIT_V(6); PG8_BAR; PG8_MMA(1, 1, At, B1); PG8_BAR;
            }
        }
        if constexpr (ALIGN_EPI) { if (wr == 0) PG8_BAR; }
        if constexpr (!Epi::AFTER_DRAIN) { E(acc, cur, wr, wc, fr, fq); S.done(cur); }
        if (!has_next) break;
#pragma unroll
        for (int a = 0; a < 2; ++a)
#pragma unroll
            for (int b = 0; b < 2; ++b)
#pragma unroll
                for (int m = 0; m < 4; ++m)
#pragma unroll
                    for (int n = 0; n < 2; ++n) acc[a][b][m][n] = (f32x4){0.f, 0.f, 0.f, 0.f};
        cur = nxt; cA = nA; cB = nB; ++ui;
        if constexpr (ALIGN_EPI) { if (wr == 1) PG8_BAR; }
    }
    PG8_WAIT_V(0);
    if constexpr (!ALIGN_EPI) { if (wr == 0) PG8_BAR; }
    PG8_BAR;
    if constexpr (Epi::AFTER_DRAIN) { E.fused(acc, cur, wr, wc, fr, fq, lds, wid, lane); S.done(cur); }
#undef PG8_SA
#undef PG8_SB
#undef PG8_STAGE
#undef PG8_LDA
#undef PG8_LDB
#undef PG8_MMA
#undef PG8_WAIT_V
#undef PG8_WAIT_L
#undef PG8_BAR
#undef PG8_SCHED
}
}
#define MFMA32(a, b, c) __builtin_amdgcn_mfma_f32_32x32x16_bf16((a), (b), (c), 0, 0, 0)
typedef __bf16 bf16x2v __attribute__((ext_vector_type(2)));
__device__ __forceinline__ unsigned cvt2(float lo, float hi) { f32x2 v = {lo, hi}; return __builtin_bit_cast(unsigned, __builtin_convertvector(v, bf16x2v)); }
#define DPP_ADD(a, ctrl) ((a) + __builtin_bit_cast(float, __builtin_amdgcn_mov_dpp(__builtin_bit_cast(int, (a)), (ctrl), 0xF, 0xF, true)))
__device__ __forceinline__ float row16_sum(float a) { a = DPP_ADD(a, 0xB1); a = DPP_ADD(a, 0x4E); a = DPP_ADD(a, 0x141); a = DPP_ADD(a, 0x140); return a; }
__device__ __forceinline__ int crow(int reg, int h) { return (reg & 3) + 8 * (reg >> 2) + 4 * h; }

constexpr int AT_KSTR = 72, AT_VSTR = 260, AT_K_BYTES = 256 * AT_KSTR * 2;
__device__ __forceinline__ void attn_item(LAS unsigned char* lds, const bf16_t* __restrict__ U, bf16_t* __restrict__ Y, const float* __restrict__ sinks, int item) {
    int tid_ = threadIdx.x; asm volatile("" : "+v"(tid_)); const int tid = tid_, lane = tid & 63, wid = tid >> 6, r = lane & 31, hh = lane >> 5;
    const int hk = item & 1, n = (item >> 1) & 31, b = item >> 6;
    LAS bf16_t* Ks = (LAS bf16_t*)lds; LAS bf16_t* Vt = (LAS bf16_t*)(lds + AT_K_BYTES);
    const long tok0 = (long)b * SEQ + 128 * (n - 1);
    for (int idx = tid; idx < 2048; idx += 512) {
        const int row = idx >> 3, ch = idx & 7;
        u32x4 kv = {0u, 0u, 0u, 0u}, vv = {0u, 0u, 0u, 0u};
        if (n > 0 || row >= 128) { const bf16_t* src = U + (size_t)(tok0 + row) * NIN + hk * 64 + ch * 8; kv = *(const u32x4*)(src + UC_K); vv = *(const u32x4*)(src + UC_V); }
        *(LAS u32x4*)(Ks + row * AT_KSTR + ch * 8) = kv;
#pragma unroll
        for (int e = 0; e < 8; ++e) Vt[(ch * 8 + e) * AT_VSTR + (row ^ (ch << 3))] = (bf16_t)(vv[e >> 1] >> (16 * (e & 1)));
    }
    LDS_BARRIER();
    const int g = wid >> 1, half = wid & 1, h = hk * 4 + g;
    const float slope = exp2f(-(float)(h + 1)), sink = sinks[h];
#pragma unroll 1
    for (int sub = 0; sub < 2; ++sub) {
        const int j = half * 2 + sub;
        const size_t qtok = (size_t)b * SEQ + 128 * n + 32 * j + r;
        bf16x8 qf[4];
#pragma unroll
        for (int s = 0; s < 4; ++s) qf[s] = *(const bf16x8*)(U + qtok * NIN + UC_Q + h * 64 + 16 * s + 8 * hh);
        f32x16 acc[5];
#pragma unroll
        for (int kt = 0; kt < 5; ++kt) {
#pragma unroll
            for (int i = 0; i < 16; ++i) acc[kt][i] = 0.f;
#pragma unroll
            for (int s = 0; s < 4; ++s) { const bf16x8 kf = *(const LAS bf16x8*)(Ks + (32 * (j + kt) + r) * AT_KSTR + 16 * s + 8 * hh); acc[kt] = MFMA32(kf, qf[s], acc[kt]); }
        }
        constexpr float L2E = 1.4426950408889634f;
        int rr = r; asm volatile("" : "+v"(rr));
        const int dq = rr - 4 * hh;
        const float sl2 = slope * L2E, sb = -sl2 * (float)(dq + 128), sink2 = sink * L2E;
        float mx = sink2;
#pragma unroll
        for (int kt = 0; kt < 5; ++kt) {
            const bool tile_ok = (n > 0) || (j + kt >= 4);
#pragma unroll
            for (int i = 0; i < 16; ++i) {
                const int c0 = 32 * kt + (i & 3) + 8 * (i >> 2), ci = (i & 3) + 8 * (i >> 2);
                float sc = fmaf(acc[kt][i], 0.125f * L2E, fmaf(sl2, (float)c0, sb));
                bool ok = tile_ok;
                if (kt == 0) ok = ok && (ci > dq);
                if (kt == 4) ok = ok && (ci <= dq);
                sc = ok ? sc : -INFINITY;
                acc[kt][i] = sc; mx = fmaxf(mx, sc);
            }
        }
        mx = fmaxf(mx, __shfl_xor(mx, 32));
        float sum = 0.f;
#pragma unroll
        for (int kt = 0; kt < 5; ++kt)
#pragma unroll
            for (int i = 0; i < 16; ++i) { const float p = __builtin_amdgcn_exp2f(acc[kt][i] - mx); acc[kt][i] = p; sum += p; }
        sum += __shfl_xor(sum, 32);
        const float inv = __builtin_amdgcn_rcpf(sum + __builtin_amdgcn_exp2f(sink2 - mx));
        f32x16 oacc[2];
#pragma unroll
        for (int dt = 0; dt < 2; ++dt)
#pragma unroll
            for (int i = 0; i < 16; ++i) oacc[dt][i] = 0.f;
#pragma unroll
        for (int kt = 0; kt < 5; ++kt)
#pragma unroll
            for (int s2 = 0; s2 < 2; ++s2) {
                u32x4 pw; pw.x = cvt2(acc[kt][8 * s2 + 0], acc[kt][8 * s2 + 1]); pw.y = cvt2(acc[kt][8 * s2 + 2], acc[kt][8 * s2 + 3]);
                pw.z = cvt2(acc[kt][8 * s2 + 4], acc[kt][8 * s2 + 5]); pw.w = cvt2(acc[kt][8 * s2 + 6], acc[kt][8 * s2 + 7]);
                const bf16x8 pf = __builtin_bit_cast(bf16x8, pw);
#pragma unroll
                for (int dt = 0; dt < 2; ++dt) {
                    const int vd = 32 * dt + r, vsw = ((vd >> 3) & 7) << 3, vk = 32 * (j + kt) + 16 * s2 + 4 * hh;
                    const s16x4 lo = *(const LAS s16x4*)(Vt + vd * AT_VSTR + (vk ^ vsw)), hi = *(const LAS s16x4*)(Vt + vd * AT_VSTR + ((vk + 8) ^ vsw));
                    const bf16x8 vf = __builtin_shufflevector(lo, hi, 0, 1, 2, 3, 4, 5, 6, 7);
                    oacc[dt] = MFMA32(vf, pf, oacc[dt]);
                }
            }
        bf16_t* yrow = Y + qtok * DM + YC_A + h * 64 + 4 * hh;
#pragma unroll
        for (int dt = 0; dt < 2; ++dt)
#pragma unroll
            for (int ig = 0; ig < 4; ++ig) {
                u32x2 w; w.x = cvt2(oacc[dt][4 * ig] * inv, oacc[dt][4 * ig + 1] * inv); w.y = cvt2(oacc[dt][4 * ig + 2] * inv, oacc[dt][4 * ig + 3] * inv);
                *(u32x2*)(yrow + 32 * dt + 8 * ig) = w;
            }
    }
    LDS_BARRIER();
}

constexpr int HST = 68, HARR = 64 * HST * 4;
constexpr int HB_ST = 72;
#define HSW(v) ((((v) >> 3) & 7) << 3)
struct HgIn { u32x4 fz, iv, qv; f32x4 s0, s1; };
__device__ __forceinline__ HgIn hg_load(const bf16_t* __restrict__ U, const float* __restrict__ HS, int item, int tid, bool full) {
    const int b = item >> 8, h = (item >> 6) & 3, c = item & 63, t = tid >> 3, k8 = (tid & 7) * 8;
    const bf16_t* src = U + ((size_t)b * SEQ + c * 64 + t) * NIN + h * 64 + k8;
    HgIn r; r.fz = *(const u32x4*)(src + UC_HF); r.iv = *(const u32x4*)(src + UC_HI);
    r.qv = *(const u32x4*)(src + UC_HQ); r.s0 = *(const f32x4*)(HS + (size_t)item * 4096 + tid * 8); r.s1 = *(const f32x4*)(HS + (size_t)item * 4096 + tid * 8 + 4);
    return r;
}
struct HgInA { u32x4 fz, iv; };
__device__ __forceinline__ HgInA hg_load_a(const bf16_t* __restrict__ U, int item, int tid) {
    const int b = item >> 8, h = (item >> 6) & 3, c = item & 63, t = tid >> 3, k8 = (tid & 7) * 8;
    const bf16_t* src = U + ((size_t)b * SEQ + c * 64 + t) * NIN + h * 64 + k8;
    HgInA r; r.fz = *(const u32x4*)(src + UC_HF); r.iv = *(const u32x4*)(src + UC_HI); return r;
}
__device__ __forceinline__ void hg_lb(const float* __restrict__ lb_logits, int layer, int h, int k8, float (&lb)[8]) {
#pragma unroll
    for (int e = 0; e < 8; ++e) { lb[e] = 0.f; if (layer == 1) { const float l0 = lb_logits[h * 64 + k8 + e], l1 = lb_logits[256 + h * 64 + k8 + e]; lb[e] = __builtin_amdgcn_rcpf(1.0f + __expf(l0 - l1)); } }
}
constexpr int HA_F = 0, HA_KK = HARR, HA_VT = 2 * HARR, HA_KD = HA_VT + 64 * HB_ST * 2, HA_SEG = HA_KD + 64 * HB_ST * 2;
__device__ __forceinline__ void hgrn_a_item(LAS unsigned char* lds, const HgInA& in, const float (&lbv)[8], int item, float* __restrict__ HS, float* __restrict__ HD) {
    int tid_ = threadIdx.x; asm volatile("" : "+v"(tid_)); const int tid = tid_, wid = tid >> 6, lane = tid & 63;
    LAS float* F = (LAS float*)(lds + HA_F); LAS float* KK = (LAS float*)(lds + HA_KK);
    LAS bf16_t* Vt = (LAS bf16_t*)(lds + HA_VT); LAS bf16_t* KdT = (LAS bf16_t*)(lds + HA_KD); LAS float* SEG = (LAS float*)(lds + HA_SEG);
    {
        const int t = tid >> 3, k8 = (tid & 7) * 8;
        const u32x4 fz = in.fz, iv = in.iv;
        float fo[8], ko[8];
#pragma unroll
        for (int e = 0; e < 8; ++e) {
            const float lb = lbv[e];
            const unsigned fw = fz[e >> 1], iw = iv[e >> 1];
            float z = (e & 1) ? bf_hi(fw) : bf_lo(fw); z = fminf(fmaxf(z, -80.f), 80.f);
            const float ez = __expf(-z), sg = __builtin_amdgcn_rcpf(1.0f + ez), sgn = ez * sg;
            fo[e] = lb + (1.0f - lb) * sg; ko[e] = (1.0f - lb) * sgn;
            Vt[(k8 + e) * HB_ST + (t ^ HSW(k8 + e))] = (bf16_t)((e & 1) ? (iw >> 16) : (iw & 0xffffu));
        }
        *(LAS f32x4*)(F + t * HST + k8) = (f32x4){fo[0], fo[1], fo[2], fo[3]}; *(LAS f32x4*)(F + t * HST + k8 + 4) = (f32x4){fo[4], fo[5], fo[6], fo[7]};
        *(LAS f32x4*)(KK + t * HST + k8) = (f32x4){ko[0], ko[1], ko[2], ko[3]}; *(LAS f32x4*)(KK + t * HST + k8 + 4) = (f32x4){ko[4], ko[5], ko[6], ko[7]};
    }
    LDS_BARRIER();
    {
        const int k = tid & 63, seg = tid >> 6; float fv[8], suf[8];
#pragma unroll
        for (int i = 0; i < 8; ++i) fv[i] = F[(8 * seg + i) * HST + k];
        suf[7] = 1.f;
#pragma unroll
        for (int i = 6; i >= 0; --i) suf[i] = suf[i + 1] * fv[i + 1];
        const float tot = suf[0] * fv[0];
        SEG[seg * 64 + k] = tot;
        LDS_BARRIER();
        float post = 1.f;
        for (int s2 = seg + 1; s2 < 8; ++s2) post *= SEG[s2 * 64 + k];
        float kd[8];
#pragma unroll
        for (int i = 0; i < 8; ++i) kd[i] = KK[(8 * seg + i) * HST + k] * suf[i] * post;
        u32x4 w; w.x = cvt2(kd[0], kd[1]); w.y = cvt2(kd[2], kd[3]); w.z = cvt2(kd[4], kd[5]); w.w = cvt2(kd[6], kd[7]);
        *(LAS u32x4*)(KdT + k * HB_ST + 8 * seg) = w;
        if (seg == 0) HD[item * 64 + k] = tot * post;
    }
    LDS_BARRIER();
    {
        const int tl = lane & 15, kq = lane >> 4, kt = wid >> 1, vt0 = 2 * (wid & 1);
        f32x4 a0 = {0.f, 0.f, 0.f, 0.f}, a1 = {0.f, 0.f, 0.f, 0.f};
#pragma unroll
        for (int ks = 0; ks < 2; ++ks) {
            const bf16x8 af = *(const LAS bf16x8*)(KdT + (16 * kt + tl) * HB_ST + 32 * ks + 8 * kq);
            const bf16x8 b0 = *(const LAS bf16x8*)(Vt + (16 * vt0 + tl) * HB_ST + ((32 * ks + 8 * kq) ^ HSW(16 * vt0 + tl))), b1 = *(const LAS bf16x8*)(Vt + (16 * (vt0 + 1) + tl) * HB_ST + ((32 * ks + 8 * kq) ^ HSW(16 * (vt0 + 1) + tl)));
            a0 = __builtin_amdgcn_mfma_f32_16x16x32_bf16(af, b0, a0, 0, 0, 0); a1 = __builtin_amdgcn_mfma_f32_16x16x32_bf16(af, b1, a1, 0, 0, 0);
        }
        float* hs = HS + (size_t)item * 4096 + (16 * kt + 4 * kq) * 64 + 16 * vt0 + tl;
#pragma unroll
        for (int i = 0; i < 4; ++i) { hs[i * 64] = a0[i]; hs[i * 64 + 16] = a1[i]; }
    }
    LDS_BARRIER();
}
constexpr int HC_F = 0, HC_KK = HARR, HC_Q = 2 * HARR, HC_BUF = 3 * HARR, HC_IMG = 64 * HB_ST * 2, HC_SET = 4 * HC_IMG, HC_QH = HC_BUF + 2 * HC_SET, HC_KB = HC_QH + HC_IMG, HC_SEG = HC_KB + HC_IMG;
__device__ __forceinline__ void hgc_out(LAS unsigned char* set, const bf16_t* __restrict__ U, int item, int tw, int lane, const float* __restrict__ gain, bf16_t* __restrict__ Y) {
    const LAS bf16_t* Vt = (const LAS bf16_t*)set; const LAS bf16_t* St = (const LAS bf16_t*)(set + HC_IMG); const LAS bf16_t* Qt = (const LAS bf16_t*)(set + 2 * HC_IMG); const LAS bf16_t* ATT = (const LAS bf16_t*)(set + 3 * HC_IMG);
    const int b = item >> 8, h = (item >> 6) & 3, c = item & 63;
    const size_t tok0 = (size_t)b * SEQ + c * 64;
    {
        const int tl = lane & 15, q4i = lane >> 4;
        f32x4 oa[4];
#pragma unroll
        for (int vt = 0; vt < 4; ++vt) oa[vt] = (f32x4){0.f, 0.f, 0.f, 0.f};
#pragma unroll
        for (int ks = 0; ks < 2; ++ks) {
            const bf16x8 b_att = *(const LAS bf16x8*)(ATT + (16 * tw + tl) * HB_ST + 32 * ks + 8 * q4i), b_q = *(const LAS bf16x8*)(Qt + (16 * tw + tl) * HB_ST + 32 * ks + 8 * q4i);
#pragma unroll
            for (int vt = 0; vt < 4; ++vt) {
                const bf16x8 a_v = *(const LAS bf16x8*)(Vt + (16 * vt + tl) * HB_ST + ((32 * ks + 8 * q4i) ^ HSW(16 * vt + tl))), a_s = *(const LAS bf16x8*)(St + (16 * vt + tl) * HB_ST + ((32 * ks + 8 * q4i) ^ HSW(16 * vt + tl)));
                oa[vt] = __builtin_amdgcn_mfma_f32_16x16x32_bf16(a_v, b_att, oa[vt], 0, 0, 0);
                oa[vt] = __builtin_amdgcn_mfma_f32_16x16x32_bf16(a_s, b_q, oa[vt], 0, 0, 0);
            }
        }
        float ss = 0.f;
#pragma unroll
        for (int vt = 0; vt < 4; ++vt) ss += (oa[vt][0] * oa[vt][0] + oa[vt][1] * oa[vt][1]) + (oa[vt][2] * oa[vt][2] + oa[vt][3] * oa[vt][3]);
        ss += __shfl_xor(ss, 16); ss += __shfl_xor(ss, 32);
        const float ri = __builtin_amdgcn_rsqf(ss * (1.0f / 64.0f) + EPS);
        const size_t tok = tok0 + 16 * tw + tl;
#pragma unroll
        for (int vt = 0; vt < 4; ++vt) {
            const int v0 = 16 * vt + 4 * q4i;
            const u32x2 gv = *(const u32x2*)(U + tok * NIN + UC_HG + h * 64 + v0);
            const f32x4 gn = *(const f32x4*)(gain + h * 64 + v0);
            const float y0 = oa[vt][0] * ri * gn[0] * siluf_(bf_lo(gv.x)), y1 = oa[vt][1] * ri * gn[1] * siluf_(bf_hi(gv.x));
            const float y2 = oa[vt][2] * ri * gn[2] * siluf_(bf_lo(gv.y)), y3 = oa[vt][3] * ri * gn[3] * siluf_(bf_hi(gv.y));
            u32x2 w; w.x = cvt2(y0, y1); w.y = cvt2(y2, y3);
            *(u32x2*)(Y + tok * DM + YC_B + h * 64 + v0) = w;
        }
    }
}
__device__ __forceinline__ void hgrn_c_item(LAS unsigned char* lds, const bf16_t* __restrict__ U, HgIn& in, const float* __restrict__ HS, int next_item, const float (&lbv)[8], int item, int prev_item, int par,
                                            const float* __restrict__ gain, bf16_t* __restrict__ Y) {
    int tid_ = threadIdx.x; asm volatile("" : "+v"(tid_)); const int tid = tid_, wid = tid >> 6, lane = tid & 63;
    LAS float* F = (LAS float*)(lds + HC_F); LAS float* KK = (LAS float*)(lds + HC_KK); LAS float* Q = (LAS float*)(lds + HC_Q);
    LAS unsigned char* set = lds + HC_BUF + par * HC_SET;
    LAS bf16_t* Vt = (LAS bf16_t*)set; LAS bf16_t* St = (LAS bf16_t*)(set + HC_IMG); LAS bf16_t* Qt = (LAS bf16_t*)(set + 2 * HC_IMG); LAS bf16_t* ATT = (LAS bf16_t*)(set + 3 * HC_IMG);
    LAS float* SEG = (LAS float*)(lds + HC_SEG);
    {
        const int t = tid >> 3, k8 = (tid & 7) * 8;
        const u32x4 fz = in.fz, iv = in.iv, qv = in.qv; const f32x4 s0 = in.s0, s1 = in.s1;
        float fo[8], ko[8], qo[8];
#pragma unroll
        for (int e = 0; e < 8; ++e) {
            const float lb = lbv[e];
            const unsigned fw = fz[e >> 1], iw = iv[e >> 1], qw = qv[e >> 1];
            float z = (e & 1) ? bf_hi(fw) : bf_lo(fw); z = fminf(fmaxf(z, -80.f), 80.f);
            const float ez = __expf(-z), sg = __builtin_amdgcn_rcpf(1.0f + ez), sgn = ez * sg;
            fo[e] = lb + (1.0f - lb) * sg; ko[e] = (1.0f - lb) * sgn;
            const float q = (e & 1) ? bf_hi(qw) : bf_lo(qw); qo[e] = siluf_(q);
            Vt[(k8 + e) * HB_ST + (t ^ HSW(k8 + e))] = (bf16_t)((e & 1) ? (iw >> 16) : (iw & 0xffffu));
            const float sv = e < 4 ? s0[e] : s1[e - 4]; St[(k8 + e) * HB_ST + (t ^ HSW(k8 + e))] = (bf16_t)cvt2(sv, sv);
        }
        *(LAS f32x4*)(F + t * HST + k8) = (f32x4){fo[0], fo[1], fo[2], fo[3]}; *(LAS f32x4*)(F + t * HST + k8 + 4) = (f32x4){fo[4], fo[5], fo[6], fo[7]};
        *(LAS f32x4*)(KK + t * HST + k8) = (f32x4){ko[0], ko[1], ko[2], ko[3]}; *(LAS f32x4*)(KK + t * HST + k8 + 4) = (f32x4){ko[4], ko[5], ko[6], ko[7]};
        *(LAS f32x4*)(Q + t * HST + k8) = (f32x4){qo[0], qo[1], qo[2], qo[3]}; *(LAS f32x4*)(Q + t * HST + k8 + 4) = (f32x4){qo[4], qo[5], qo[6], qo[7]};
    }
    LDS_BARRIER();
    {
        LAS bf16_t* QH = (LAS bf16_t*)(lds + HC_QH); LAS bf16_t* KB = (LAS bf16_t*)(lds + HC_KB);
        const int k = tid & 63, seg = tid >> 6; float run = 1.f, pv[8], fv[8];
#pragma unroll
        for (int i = 0; i < 8; ++i) { fv[i] = F[(8 * seg + i) * HST + k]; run *= fv[i]; pv[i] = run; }
        SEG[seg * 64 + k] = run;
        LDS_BARRIER();
        float pre = 1.f;
        for (int s2 = 0; s2 < seg; ++s2) pre *= SEG[s2 * 64 + k];
        const float preb = (seg & 1) ? SEG[(seg - 1) * 64 + k] : 1.f, postb = (seg & 1) ? 1.f : SEG[(seg + 1) * 64 + k];
        float suf = 1.f;
#pragma unroll
        for (int i = 7; i >= 0; --i) { const int row = 8 * seg + i; const float qv_ = Q[row * HST + k];
            const float qp = qv_ * (pv[i] * pre), qh = qv_ * (pv[i] * preb), kb = KK[row * HST + k] * (suf * postb);
            Qt[row * HB_ST + k] = (bf16_t)cvt2(qp, qp); QH[row * HB_ST + k] = (bf16_t)cvt2(qh, qh); KB[row * HB_ST + k] = (bf16_t)cvt2(kb, kb); suf *= fv[i]; }
    }
    LDS_BARRIER();
    if (wid < 4) {
        const int base = 16 * wid, sa = (tid >> 3) & 7, kq = tid & 7, nA = 16 - sa, ra = base + sa, rb = base + 15 - sa;
        f32x4 w0 = *(const LAS f32x4*)(KK + ra * HST + 8 * kq), w1 = *(const LAS f32x4*)(KK + ra * HST + 8 * kq + 4);
        const f32x4 wB0 = *(const LAS f32x4*)(KK + rb * HST + 8 * kq), wB1 = *(const LAS f32x4*)(KK + rb * HST + 8 * kq + 4);
#define HGC_DOT() (((q0[0] * w0[0] + q0[1] * w0[1]) + (q0[2] * w0[2] + q0[3] * w0[3])) + ((q1[0] * w1[0] + q1[1] * w1[1]) + (q1[2] * w1[2] + q1[3] * w1[3])))
#define HGC_STORE(t_, s_) do { a = DPP_ADD(a, 0xB1); a = DPP_ADD(a, 0x4E); a = DPP_ADD(a, 0x141); if (kq == 0) ATT[(t_) * HB_ST + (s_)] = (bf16_t)cvt2(a, a); } while (0)
        {
            const f32x4 q0 = *(const LAS f32x4*)(Q + ra * HST + 8 * kq), q1 = *(const LAS f32x4*)(Q + ra * HST + 8 * kq + 4);
            float a = HGC_DOT(); HGC_STORE(ra, ra);
        }
#pragma unroll
        for (int j = 1; j < 9; ++j) {
            const int t = ra + j;
            const f32x4 f0 = *(const LAS f32x4*)(F + t * HST + 8 * kq), f1 = *(const LAS f32x4*)(F + t * HST + 8 * kq + 4);
            const f32x4 q0 = *(const LAS f32x4*)(Q + t * HST + 8 * kq), q1 = *(const LAS f32x4*)(Q + t * HST + 8 * kq + 4);
            w0 = w0 * f0; w1 = w1 * f1;
            float a = HGC_DOT(); HGC_STORE(t, ra);
        }
#pragma unroll
        for (int j = 9; j < 17; ++j) {
            const bool inA = j < nA; const int s = inA ? ra : rb; const int t = inA ? ra + j : rb + (j - nA);
            const f32x4 f0 = *(const LAS f32x4*)(F + t * HST + 8 * kq), f1 = *(const LAS f32x4*)(F + t * HST + 8 * kq + 4);
            const f32x4 q0 = *(const LAS f32x4*)(Q + t * HST + 8 * kq), q1 = *(const LAS f32x4*)(Q + t * HST + 8 * kq + 4);
            if (j == nA) { w0 = wB0; w1 = wB1; } else { w0 = w0 * f0; w1 = w1 * f1; }
            float a = HGC_DOT(); HGC_STORE(t, s);
        }
#undef HGC_DOT
#undef HGC_STORE
        {
            const LAS bf16_t* QH = (const LAS bf16_t*)(lds + HC_QH); const LAS bf16_t* KB = (const LAS bf16_t*)(lds + HC_KB);
            const int tl = lane & 15, q4i = lane >> 4;
            for (int ti = wid; ti < 6; ti += 4) {
                const int I = ti < 1 ? 1 : (ti < 3 ? 2 : 3), J = ti - (I * (I - 1)) / 2;
                f32x4 d = {0.f, 0.f, 0.f, 0.f};
#pragma unroll
                for (int ks = 0; ks < 2; ++ks) {
                    bf16x8 af = *(const LAS bf16x8*)(QH + (16 * I + tl) * HB_ST + 32 * ks + 8 * q4i);
                    const bf16x8 bfr = *(const LAS bf16x8*)(KB + (16 * J + tl) * HB_ST + 32 * ks + 8 * q4i);
                    if (I - J >= 2) {
                        const LAS float* sg = SEG + 32 * ks + 8 * q4i;
                        f32x4 g0 = *(const LAS f32x4*)(sg + (2 * (J + 1)) * 64) * *(const LAS f32x4*)(sg + (2 * (J + 1) + 1) * 64), g1 = *(const LAS f32x4*)(sg + (2 * (J + 1)) * 64 + 4) * *(const LAS f32x4*)(sg + (2 * (J + 1) + 1) * 64 + 4);
                        if (I - J == 3) { g0 = g0 * *(const LAS f32x4*)(sg + (2 * (J + 2)) * 64) * *(const LAS f32x4*)(sg + (2 * (J + 2) + 1) * 64); g1 = g1 * *(const LAS f32x4*)(sg + (2 * (J + 2)) * 64 + 4) * *(const LAS f32x4*)(sg + (2 * (J + 2) + 1) * 64 + 4); }
                        const u32x4 aw = __builtin_bit_cast(u32x4, af);
                        u32x4 o; o.x = cvt2(bf_lo(aw.x) * g0[0], bf_hi(aw.x) * g0[1]); o.y = cvt2(bf_lo(aw.y) * g0[2], bf_hi(aw.y) * g0[3]); o.z = cvt2(bf_lo(aw.z) * g1[0], bf_hi(aw.z) * g1[1]); o.w = cvt2(bf_lo(aw.w) * g1[2], bf_hi(aw.w) * g1[3]);
                        af = __builtin_bit_cast(bf16x8, o);
                    }
                    d = __builtin_amdgcn_mfma_f32_16x16x32_bf16(af, bfr, d, 0, 0, 0);
                }
#pragma unroll
                for (int i = 0; i < 4; ++i) ATT[(16 * I + 4 * q4i + i) * HB_ST + 16 * J + tl] = (bf16_t)cvt2(d[i], d[i]);
            }
        }
    }
    else {
        if (prev_item >= 0) hgc_out(lds + HC_BUF + (par ^ 1) * HC_SET, U, prev_item, wid - 4, lane, gain, Y);
    }
    if (next_item >= 0) in = hg_load(U, HS, next_item, tid, true);
    LDS_BARRIER();
}
__device__ __forceinline__ void hgrn_c_init(LAS unsigned char* lds) {
    int tid_ = threadIdx.x; asm volatile("" : "+v"(tid_));
    for (int i = tid_; i < 2 * (HC_IMG / 4); i += 512) { const int set = i / (HC_IMG / 4), w = i - set * (HC_IMG / 4); ((LAS unsigned*)(lds + HC_BUF + set * HC_SET + 3 * HC_IMG))[w] = 0u; }
    LDS_BARRIER();
}
__device__ __forceinline__ void hgrn_c_tail(LAS unsigned char* lds, const bf16_t* __restrict__ U, int prev_item, int par_prev, const float* __restrict__ gain, bf16_t* __restrict__ Y) {
    int tid_ = threadIdx.x; asm volatile("" : "+v"(tid_)); const int wid = tid_ >> 6, lane = tid_ & 63;
    if (wid >= 4 && prev_item >= 0) hgc_out(lds + HC_BUF + par_prev * HC_SET, U, prev_item, wid - 4, lane, gain, Y);
    LDS_BARRIER();
}

constexpr int S5_XST = 132, S5_XS_BYTES = 16 * S5_XST * 4, S5_ZB_OFF = 8 * S5_XS_BYTES, S5_ZST = 264;
#define MFMA16(a, b, c) __builtin_amdgcn_mfma_f32_16x16x32_bf16((a), (b), (c), 0, 0, 0)
__device__ __forceinline__ void s5_bu_tile(LAS float* BU, const bf16x8 af, const bf16x8 (&bfr)[8], int tl, int kq) {
#pragma unroll
    for (int ct = 0; ct < 8; ++ct) { const f32x4 d = MFMA16(af, bfr[ct], ((f32x4){0.f, 0.f, 0.f, 0.f}));
#pragma unroll
        for (int i = 0; i < 4; ++i) BU[(4 * kq + i) * S5_XST + 16 * ct + tl] = d[i]; }
}
__device__ __forceinline__ void s5_a_item(LAS unsigned char* lds, const bf16_t* __restrict__ U, const f32x4* __restrict__ SP, const bf16_t* __restrict__ BBh, int layer, int item, f32x2* __restrict__ SE) {
    int tid_ = threadIdx.x; asm volatile("" : "+v"(tid_)); const int tid = tid_, lane = tid & 63, wid = tid >> 6, tl = lane & 15, kq = lane >> 4;
    const size_t tok0 = (size_t)item * 64;
    LAS float* BU = (LAS float*)(lds + wid * S5_XS_BYTES);
    const bf16x8 zf = {0, 0, 0, 0, 0, 0, 0, 0};
#pragma unroll 1
    for (int gi = 0; gi < 2; ++gi) {
        const int g = wid + 8 * gi, lg = layer * 16 + g;
        const f32x4 sp = SP[lg * 64 + lane];
        bf16x8 bfr[8], af[4];
#pragma unroll
        for (int ct = 0; ct < 8; ++ct) bfr[ct] = kq < 2 ? *(const bf16x8*)(BBh + ((size_t)lg * 128 + 16 * ct + tl) * 16 + 8 * kq) : zf;
#pragma unroll
        for (int sc = 0; sc < 4; ++sc) af[sc] = kq < 2 ? *(const bf16x8*)(U + (tok0 + 16 * sc + tl) * NIN + UC_S5 + g * 16 + 8 * kq) : zf;
        float xr = 0.f, xi = 0.f;
#pragma unroll
        for (int sc = 0; sc < 4; ++sc) {
            s5_bu_tile(BU, af[sc], bfr, tl, kq);
            LDS_WAIT();
#pragma unroll
            for (int tt = 0; tt < 16; ++tt) { const f32x2 bu = *(const LAS f32x2*)(BU + tt * S5_XST + 2 * lane);
                const float nr = sp[0] * xr - sp[1] * xi + bu[0], ni = sp[0] * xi + sp[1] * xr + bu[1]; xr = nr; xi = ni; }
            LDS_WAIT();
        }
        SE[((size_t)item * 16 + g) * 64 + lane] = (f32x2){xr, xi};
    }
}
__device__ __forceinline__ void s5_c_item(LAS unsigned char* lds, const bf16_t* __restrict__ U, const f32x4* __restrict__ SP, const bf16_t* __restrict__ BBh, const bf16_t* __restrict__ CMh,
                                          const float* __restrict__ dsk, const bf16_t* __restrict__ WgT, const float* __restrict__ gbias, int layer, int item, const f32x2* __restrict__ SE, bf16_t* __restrict__ Y) {
    int tid_ = threadIdx.x; asm volatile("" : "+v"(tid_)); const int tid = tid_, lane = tid & 63, wid = tid >> 6, tl = lane & 15, kq = lane >> 4;
    const size_t tok0 = (size_t)item * 64;
    LAS float* XS = (LAS float*)(lds + wid * S5_XS_BYTES); LAS bf16_t* ZB = (LAS bf16_t*)(lds + S5_ZB_OFF);
    const bf16x8 zf = {0, 0, 0, 0, 0, 0, 0, 0};
    const int ch = tl;
#pragma unroll 1
    for (int gi = 0; gi < 2; ++gi) {
        const int g = wid + 8 * gi, lg = layer * 16 + g;
        const f32x4 sp = SP[lg * 64 + lane];
        bf16x8 bfr[8], af[4];
#pragma unroll
        for (int ct = 0; ct < 8; ++ct) bfr[ct] = kq < 2 ? *(const bf16x8*)(BBh + ((size_t)lg * 128 + 16 * ct + tl) * 16 + 8 * kq) : zf;
#pragma unroll
        for (int sc = 0; sc < 4; ++sc) af[sc] = kq < 2 ? *(const bf16x8*)(U + (tok0 + 16 * sc + tl) * NIN + UC_S5 + g * 16 + 8 * kq) : zf;
        bf16x8 cmf[4];
#pragma unroll
        for (int ks = 0; ks < 4; ++ks) cmf[ks] = *(const bf16x8*)(CMh + ((size_t)lg * 16 + ch) * 128 + 32 * ks + 8 * kq);
        float uq[16];
#pragma unroll
        for (int q = 0; q < 16; ++q) uq[q] = bf_lo((unsigned)U[(tok0 + 16 * (q >> 2) + 4 * kq + (q & 3)) * NIN + UC_S5 + g * 16 + ch]);
        const float dv = dsk[lg * 16 + ch];
        const f32x2 x0 = SE[((size_t)item * 16 + g) * 64 + lane];
        float xr = x0[0], xi = x0[1];
#pragma unroll
        for (int sc = 0; sc < 4; ++sc) {
            s5_bu_tile(XS, af[sc], bfr, tl, kq);
            LDS_WAIT();
#pragma unroll
            for (int tt = 0; tt < 16; ++tt) { LAS f32x2* xp = (LAS f32x2*)(XS + tt * S5_XST + 2 * lane); const f32x2 bu = *xp;
                const float nr = sp[0] * xr - sp[1] * xi + bu[0], ni = sp[0] * xi + sp[1] * xr + bu[1]; xr = nr; xi = ni; *xp = (f32x2){xr, xi}; }
            LDS_WAIT();
            f32x4 ya = {0.f, 0.f, 0.f, 0.f};
#pragma unroll
            for (int ks = 0; ks < 4; ++ks) { const f32x4 xa = *(const LAS f32x4*)(XS + tl * S5_XST + 32 * ks + 8 * kq), xb = *(const LAS f32x4*)(XS + tl * S5_XST + 32 * ks + 8 * kq + 4);
                u32x4 aw; aw.x = cvt2(xa[0], xa[1]); aw.y = cvt2(xa[2], xa[3]); aw.z = cvt2(xb[0], xb[1]); aw.w = cvt2(xb[2], xb[3]);
                ya = MFMA16(__builtin_bit_cast(bf16x8, aw), cmf[ks], ya); }
#pragma unroll
            for (int i = 0; i < 4; ++i) { const int t = 16 * sc + 4 * kq + i;
                { const float zv = gelu_tanh(ya[i] + dv * uq[4 * sc + i]); ZB[t * S5_ZST + g * 16 + ch] = (bf16_t)cvt2(zv, zv); } }
            LDS_WAIT();
        }
    }
    LDS_BARRIER();
    {
        const int r = lane & 31, hh = lane >> 5, n0 = 32 * wid;
        f32x16 ga[2];
#pragma unroll
        for (int mt = 0; mt < 2; ++mt)
#pragma unroll
            for (int i = 0; i < 16; ++i) ga[mt][i] = 0.f;
#pragma unroll 4
        for (int s = 0; s < 16; ++s) {
            const bf16x8 wfr = *(const bf16x8*)(WgT + (size_t)layer * 65536 + (n0 + r) * 256 + 16 * s + 8 * hh);
#pragma unroll
            for (int mt = 0; mt < 2; ++mt) { const bf16x8 zfr = *(const LAS bf16x8*)(ZB + (32 * mt + r) * S5_ZST + 16 * s + 8 * hh); ga[mt] = MFMA32(wfr, zfr, ga[mt]); }
        }
#pragma unroll
        for (int ig = 0; ig < 4; ++ig) {
            const int nn = n0 + 8 * ig + 4 * hh;
            const f32x4 bias = *(const f32x4*)(gbias + layer * 256 + nn);
#pragma unroll
            for (int mt = 0; mt < 2; ++mt) { const int t = 32 * mt + r;
                const u32x2 zw = *(const LAS u32x2*)(ZB + t * S5_ZST + nn);
                const float o0 = bf_lo(zw.x) * sigmoidf_(ga[mt][4 * ig] + bias[0]), o1 = bf_hi(zw.x) * sigmoidf_(ga[mt][4 * ig + 1] + bias[1]);
                const float o2 = bf_lo(zw.y) * sigmoidf_(ga[mt][4 * ig + 2] + bias[2]), o3 = bf_hi(zw.y) * sigmoidf_(ga[mt][4 * ig + 3] + bias[3]);
                u32x2 w; w.x = cvt2(o0, o1); w.y = cvt2(o2, o3);
                *(u32x2*)(Y + (tok0 + t) * DM + YC_C + nn) = w; }
        }
    }
    LDS_BARRIER();
}

#define XB_TMO      128
#define XB_XCNT(j)  (256  + 64 * (j))
#define XB_XSUB(j)  (1280 + 64 * (j))
#define XB_XGEN(j)  (2304 + 64 * (j))
#define XB_TOP      3328
#define XB_TOPGEN   3392
#define XCD_BAR_WORDS 3456
#define XB_SPIN_CAP (1u << 18)

__device__ __forceinline__ unsigned xb_ld(unsigned* p)              { return __hip_atomic_load(p, __ATOMIC_RELAXED, __HIP_MEMORY_SCOPE_AGENT); }
__device__ __forceinline__ unsigned xb_add(unsigned* p, unsigned v) { return __hip_atomic_fetch_add(p, v, __ATOMIC_RELAXED, __HIP_MEMORY_SCOPE_AGENT); }
__device__ __forceinline__ unsigned xb_xcc_id() { return (unsigned)__builtin_amdgcn_s_getreg((3 << 11) | 20) & 0xFu; }
#define XB_SPIN(cond, bar) do { unsigned _sp = 0; while (cond) { __builtin_amdgcn_s_sleep(1); \
    if ((++_sp & 255u) == 0u) { if (xb_ld(&(bar)[XB_TMO])) break; if (_sp > XB_SPIN_CAP) { atomicAdd(&(bar)[XB_TMO], 1u); break; } } } } while (0)

struct XcdBarrier {
    unsigned* bar; unsigned x;
    volatile LAS unsigned* st;
};

__device__ __forceinline__ XcdBarrier xcd_barrier_post(unsigned* bar, volatile LAS unsigned* st) {
    XcdBarrier b; b.bar = bar; b.x = xb_xcc_id(); b.st = st;
    if (threadIdx.x == 0) (void)xb_add(&bar[XB_XCNT(b.x)], 1u);
    return b;
}
__device__ __forceinline__ void xcd_barrier_complete(unsigned* bar, unsigned x, unsigned& nloc, unsigned& nx) {
    const unsigned G = gridDim.x * gridDim.y * gridDim.z;
    unsigned sum, cnt, mine, sp = 0u;
    for (;;) {
        sum = 0u; cnt = 0u; mine = 0u;
#pragma unroll
        for (unsigned j = 0; j < 16; ++j) { const unsigned c = xb_ld(&bar[XB_XCNT(j)]); sum += c; cnt += (c > 0u) ? 1u : 0u; mine = (j == x) ? c : mine; }
        if (sum == G) break;
        __builtin_amdgcn_s_sleep(1);
        if ((++sp & 255u) == 0u) { if (xb_ld(&bar[XB_TMO])) break; if (sp > XB_SPIN_CAP) { atomicAdd(&bar[XB_TMO], 1u); break; } }
    }
    nloc = mine > 0u ? mine : 1u; nx = cnt > 0u ? cnt : 1u;
}

__device__ __forceinline__ void xcd_barrier(const XcdBarrier& b) {
    asm volatile("s_waitcnt vmcnt(0)" ::: "memory");
    __syncthreads();
    if (threadIdx.x == 0) {
        unsigned* bar = b.bar;
        __builtin_amdgcn_s_waitcnt(0);
        unsigned nloc = b.st[0], nx = b.st[1];
        if (nloc == 0u) { xcd_barrier_complete(bar, b.x, nloc, nx); b.st[0] = nloc; b.st[1] = nx; }
        const unsigned old = xb_add(&bar[XB_XSUB(b.x)], 1u);
        const unsigned gen = old / nloc;
        if (old + 1u == (gen + 1u) * nloc) {
            __builtin_amdgcn_fence(__ATOMIC_RELEASE, "agent");
            asm volatile("s_waitcnt vmcnt(0)" ::: "memory");
            const unsigned og = xb_add(&bar[XB_TOP], 1u);
            const unsigned tg = og / nx;
            if (og + 1u == (tg + 1u) * nx) xb_add(&bar[XB_TOPGEN], 1u);
            else XB_SPIN(xb_ld(&bar[XB_TOPGEN]) == tg, bar);
            __builtin_amdgcn_fence(__ATOMIC_ACQUIRE, "agent");
            xb_add(&bar[XB_XGEN(b.x)], 1u);
            asm volatile("s_waitcnt vmcnt(0)" ::: "memory");
        } else {
            XB_SPIN(xb_ld(&bar[XB_XGEN(b.x)]) == gen, bar);
            __builtin_amdgcn_fence(__ATOMIC_ACQUIRE, "agent");
            asm volatile("s_waitcnt vmcnt(0)" ::: "memory");
        }
    }
    __syncthreads();
}
constexpr size_t MiB = 1u << 20;
constexpr size_t WL_GU1 = 0, WL_D1 = WL_GU1 + (size_t)NGU * DM * 2, WL_IN = WL_D1 + (size_t)DM * DFF * 2, WL_OUT = WL_IN + (size_t)NIN * DM * 2,
                 WL_GU2 = WL_OUT + (size_t)DM * DM * 2, WL_D2 = WL_GU2 + (size_t)NGU * DM * 2, WL_SIZE = WL_D2 + (size_t)DM * DFF * 2;
static_assert(WL_SIZE * 2 <= 90 * MiB, "weights");
constexpr size_t WS_W = 0;
constexpr size_t WS_WG = 90 * MiB;
constexpr size_t WS_SP = 91 * MiB;
constexpr size_t WS_BB = 92 * MiB;
constexpr size_t WS_CM = 92 * MiB + 512 * 1024;
constexpr size_t WS_SSQ = 93 * MiB;
constexpr size_t WS_HD = 94 * MiB;
constexpr size_t WS_SE = 95 * MiB;
constexpr size_t WS_CTL = 99 * MiB;
constexpr size_t WS_FX = 99 * MiB + 64 * 1024;
constexpr size_t WS_XB = 100 * MiB;
constexpr size_t WS_G1 = 164 * MiB;
constexpr size_t WS_Y = 340 * MiB;
constexpr size_t WS_HS = 404 * MiB;
constexpr size_t WS_END = 436 * MiB;

constexpr int LDS_BYTES = 147456;
constexpr int LDS_RING = 131072;

struct Args {
    const float* in[26]; float* out; unsigned char* ws; int ph_lo, ph_hi;
};

constexpr int LDS_RINV = LDS_RING + 4096 + 512;
constexpr int LDS_TAB = LDS_BYTES - 512;
__device__ __forceinline__ const float* inptr(LAS unsigned char* lds, int i) {
    const u32x2 v = *(const LAS u32x2*)(lds + LDS_TAB + 8 * i);
    const unsigned lo = __builtin_amdgcn_readfirstlane(v.x), hi = __builtin_amdgcn_readfirstlane(v.y);
    return (const float*)(((unsigned long long)hi << 32) | lo);
}
#define INP(i) inptr(lds, (i))
__device__ __forceinline__ void p0_transpose_item(const float* __restrict__ W, int K, int N, const float* __restrict__ gain, bf16_t* __restrict__ WT, int k0, int n0, int orow0, LAS float* scr, int lane) {
    const int kr = lane >> 4, n4 = 4 * (lane & 15);
    f32x4 v[16];
#pragma unroll
    for (int i = 0; i < 16; ++i) v[i] = __builtin_nontemporal_load((const f32x4*)(W + (size_t)(k0 + 4 * i + kr) * N + n0 + n4));
    const int c = lane & 7;
    f32x4 g0 = {1.f, 1.f, 1.f, 1.f}, g1 = {1.f, 1.f, 1.f, 1.f};
    if (gain) { g0 = *(const f32x4*)(gain + k0 + 8 * c); g1 = *(const f32x4*)(gain + k0 + 8 * c + 4); }
#pragma unroll
    for (int i = 0; i < 16; ++i) { LAS float* d = scr + (4 * i + kr) * 65 + n4; d[0] = v[i][0]; d[1] = v[i][1]; d[2] = v[i][2]; d[3] = v[i][3]; }
    LDS_WAIT();
#pragma unroll
    for (int j = 0; j < 8; ++j) { const int n = (lane >> 3) + 8 * j; const LAS float* s = scr + (8 * c) * 65 + n;
        u32x4 o; o.x = pk2(s[0 * 65] * g0[0], s[1 * 65] * g0[1]); o.y = pk2(s[2 * 65] * g0[2], s[3 * 65] * g0[3]); o.z = pk2(s[4 * 65] * g1[0], s[5 * 65] * g1[1]); o.w = pk2(s[6 * 65] * g1[2], s[7 * 65] * g1[3]);
        __builtin_nontemporal_store(o, (u32x4*)(WT + (size_t)(orow0 + n) * K + k0 + 8 * c)); }
    LDS_WAIT();
}
__device__ __forceinline__ float wave_sum(float v) {
#pragma unroll
    for (int o = 1; o < 64; o <<= 1) v += __shfl_xor(v, o);
    return v;
}
__device__ __forceinline__ int gu_row(int n0, int up) { return (n0 >> 7) * 256 + (n0 & 127) + up * 128; }

__device__ __forceinline__ void p0_prologue(LAS unsigned char* lds, unsigned char* ws) {
    const int tid = threadIdx.x, lane = tid & 63, wid = tid >> 6;
    LAS float* scr = (LAS float*)(lds + wid * 16640);
    const int gw = blockIdx.x * 8 + wid, NGW = gridDim.x * 8;
    constexpr int I_G = 16 * 44, I_D = 44 * 16, I_IN = 16 * 32, I_O = 16 * 16, I_L = 6 * I_G + I_IN + I_O;
    static_assert(I_G == I_D, "item counts");
    for (int it = gw; it < DEPTH * I_L; it += NGW) {
        const int layer = it / I_L; int r = it % I_L;
        bf16_t* wl = (bf16_t*)(ws + WS_W + (size_t)layer * WL_SIZE);
        const int seg = r < 6 * I_G ? r / I_G : (r < 6 * I_G + I_IN ? 6 : 7);
        if (seg < 6) { r -= seg * I_G;
            const int ffn = seg / 3, kind = seg % 3;
            if (kind < 2) { const int kb = r / 44, nb = r % 44; const float* W = INP((ffn ? 22 : 2) + kind) + (size_t)layer * DM * DFF; const float* gn = INP(ffn ? 21 : 1) + layer * DM;
                p0_transpose_item(W, DM, DFF, gn, (bf16_t*)((unsigned char*)wl + (ffn ? WL_GU2 : WL_GU1)), 64 * kb, 64 * nb, gu_row(64 * nb, kind), scr, lane); }
            else { const int kb = r / 16, nb = r % 16; const float* W = INP(ffn ? 24 : 4) + (size_t)layer * DFF * DM;
                p0_transpose_item(W, DFF, DM, nullptr, (bf16_t*)((unsigned char*)wl + (ffn ? WL_D2 : WL_D1)), 64 * kb, 64 * nb, 64 * nb, scr, lane); }
        } else if (seg == 6) { r -= 6 * I_G; const int kb = r / 32, nb = r % 32;
            p0_transpose_item(INP(6) + (size_t)layer * DM * NIN, DM, NIN, INP(5) + layer * DM, (bf16_t*)((unsigned char*)wl + WL_IN), 64 * kb, 64 * nb, 64 * nb, scr, lane);
        } else { r -= 6 * I_G + I_IN; const int kb = r / 16, nb = r % 16;
            p0_transpose_item(INP(20) + (size_t)layer * DM * DM, DM, DM, nullptr, (bf16_t*)((unsigned char*)wl + WL_OUT), 64 * kb, 64 * nb, 64 * nb, scr, lane); }
    }
    {
        const float* x = INP(0); bf16_t* XB = (bf16_t*)(ws + WS_XB); float* ssq = (float*)(ws + WS_SSQ);
        for (int m = 4 * gw; m < MTOK; m += 4 * NGW) {
            const f32x4* xr = (const f32x4*)(x + (size_t)m * DM) + lane; float sq[4] = {0.f, 0.f, 0.f, 0.f};
            u32x2* o8 = (u32x2*)(XB + (size_t)m * DM) + lane;
            f32x4 v[16];
#pragma unroll
            for (int j = 0; j < 16; ++j) v[j] = __builtin_nontemporal_load(xr + 64 * j);
#pragma unroll
            for (int j = 0; j < 16; ++j) { sq[j >> 2] += (v[j][0] * v[j][0] + v[j][1] * v[j][1]) + (v[j][2] * v[j][2] + v[j][3] * v[j][3]);
                u32x2 w; w.x = pk2(v[j][0], v[j][1]); w.y = pk2(v[j][2], v[j][3]); o8[64 * j] = w; }
#pragma unroll
            for (int q = 0; q < 4; ++q) sq[q] = wave_sum(sq[q]);
            if (lane < 16) ssq[4 * (size_t)m + lane] = (lane & 3) ? 0.f : (lane == 0 ? sq[0] : (lane == 4 ? sq[1] : (lane == 8 ? sq[2] : sq[3])));
        }
    }
    {
        const int gt = blockIdx.x * 512 + tid, NT = gridDim.x * 512;
        f32x4* SP = (f32x4*)(ws + WS_SP); bf16_t* BB = (bf16_t*)(ws + WS_BB); bf16_t* WgT = (bf16_t*)(ws + WS_WG);
        for (int e = gt; e < DEPTH * 16 * 64; e += NT) {
            const int lg = e >> 6;
            const float dt = expf(INP(12)[lg]), ar = INP(10)[e], ai = INP(11)[e];
            const float mag = expf(ar * dt), ang = ai * dt, abr = mag * cosf(ang), abi = mag * sinf(ang);
            float pr = abr, pi = abi;
#pragma unroll
            for (int q = 0; q < 6; ++q) { const float nr = pr * pr - pi * pi, ni = 2.f * pr * pi; pr = nr; pi = ni; }
            SP[e] = (f32x4){abr, abi, pr, pi};
            const float nr = abr - 1.0f, ni = abi, den = ar * ar + ai * ai, zr = (nr * ar + ni * ai) / den, zi = (ni * ar - nr * ai) / den;
#pragma unroll 4
            for (int c = 0; c < 16; ++c) { const float br = INP(13)[(size_t)e * 16 + c], bi = INP(14)[(size_t)e * 16 + c];
                BB[((size_t)e * 2 + 0) * 16 + c] = (bf16_t)f2bf(zr * br - zi * bi); BB[((size_t)e * 2 + 1) * 16 + c] = (bf16_t)f2bf(zr * bi + zi * br); }
        }
        {   bf16_t* CMh = (bf16_t*)(ws + WS_CM);
            for (int e = gt; e < DEPTH * 16 * 16 * 128; e += NT) { const int k = e & 127, ch = (e >> 7) & 15, lg = e >> 11, pp = k >> 1;
                const float v = (k & 1) ? -INP(16)[((size_t)lg * 16 + ch) * 64 + pp] : INP(15)[((size_t)lg * 16 + ch) * 64 + pp]; CMh[e] = (bf16_t)f2bf(v); } }
        for (int e = gt; e < DEPTH * 65536; e += NT) { const int layer = e >> 16, n = (e >> 8) & 255, k = e & 255; WgT[e] = (bf16_t)f2bf(INP(18)[(size_t)layer * 65536 + k * 256 + n]); }
    }
}

constexpr int N_PHASES = 1 + 9 * DEPTH + 1;
__global__ void __launch_bounds__(512, 2) fwd_kernel(Args A) {
    extern __shared__ __attribute__((aligned(16))) unsigned char lds_raw[];
    LAS unsigned char* lds = (LAS unsigned char*)lds_raw;
    cg::grid_group grid = cg::this_grid();
    const int lo = A.ph_lo, hi = A.ph_hi, G = gridDim.x, bid0 = blockIdx.x, tid = threadIdx.x;
    unsigned char* ws = A.ws;
    if (tid < 26) *(LAS u32x2*)(lds + LDS_TAB + 8 * tid) = __builtin_bit_cast(u32x2, A.in[tid]);
    if (tid < 2) *(LAS unsigned*)(lds + LDS_TAB + 256 + 4 * tid) = 0u;
    __syncthreads();
    const XcdBarrier bar = xcd_barrier_post((unsigned*)(ws + WS_CTL), (volatile LAS unsigned*)(lds + LDS_TAB + 256));
    bf16_t* XB = (bf16_t*)(ws + WS_XB); bf16_t* G1 = (bf16_t*)(ws + WS_G1); bf16_t* Ub = (bf16_t*)(ws + WS_G1); bf16_t* Yb = (bf16_t*)(ws + WS_Y);
    float* SSQ = (float*)(ws + WS_SSQ); float* HS = (float*)(ws + WS_HS); float* HD = (float*)(ws + WS_HD); f32x2* SE = (f32x2*)(ws + WS_SE);
    const f32x4* SP = (const f32x4*)(ws + WS_SP); const bf16_t* BB = (const bf16_t*)(ws + WS_BB); const bf16_t* WgT = (const bf16_t*)(ws + WS_WG);
    float* out = A.out;
#define IN(k) (lo <= (k) && (k) < hi)
#ifndef REP_SYNC
#define REP_SYNC 1
#endif
#define SEAM(k) do { if (IN(k) && IN((k) + 1)) { for (int rs_ = 0; rs_ < REP_SYNC; ++rs_) { if ((k) == 0) grid.sync(); else xcd_barrier(bar); } } } while (0)

#ifndef REP_HGC
#define REP_HGC 1
#endif
#ifndef REP_HGA
#define REP_HGA 1
#endif
#ifndef REP_S5A
#define REP_S5A 1
#endif
#ifndef REP_P0
#define REP_P0 1
#endif
#ifndef REP_MIXA
#define REP_MIXA 1
#endif
#ifndef REP_MIXC
#define REP_MIXC 1
#endif
#ifndef REP_GU
#define REP_GU 1
#endif
#ifndef REP_INP
#define REP_INP 1
#endif
    if (IN(0)) { for (int rep = 0; rep < REP_P0; ++rep) { p0_prologue(lds, ws); __syncthreads(); } }
    SEAM(0);
#pragma unroll 1
    for (int layer = 0; layer < DEPTH; ++layer) {
        const int pb = 1 + 9 * layer;
        int bid = bid0; asm volatile("" : "+s"(bid));
        const unsigned char* wl = ws + WS_W + (size_t)layer * WL_SIZE;
#pragma unroll 1
        for (int ffn = 0; ffn < 2; ++ffn) {
            const int p_gu = pb + (ffn ? 7 : 0), p_dn = p_gu + 1;
            if (IN(p_gu)) for (int rep = 0; rep < REP_GU; ++rep) {
#ifndef SKIP_GU
                pg8::Gemm g{XB, (const bf16_t*)(wl + (ffn ? WL_GU2 : WL_GU1)), MTOK, NGU, DM}; pg8::RinvOrder S; S.init(MTOK, NGU, G, bid); S.ssq = SSQ; S.tab = lds + LDS_RINV; S.par = 0;
                pg8::EpiSwiglu E{G1, lds + LDS_RINV, 0};
                pg8::gemm_phase<pg8::EpiSwiglu, pg8::RinvOrder, true, true>(lds, g, S, E);
#ifdef PROBE_GU5
                { pg8::Gemm g5{XB, (const bf16_t*)(wl + (ffn ? WL_GU2 : WL_GU1)), MTOK, 2560, DM}; pg8::RinvOrder S5o; S5o.init(MTOK, 2560, G, bid); S5o.ssq = SSQ; S5o.tab = lds + LDS_RINV; S5o.par = 0;
                  pg8::EpiSwiglu E5{G1, lds + LDS_RINV, 0};
                  pg8::gemm_phase<pg8::EpiSwiglu, pg8::RinvOrder, true, true>(lds, g5, S5o, E5); }
#endif
#endif
            }
            SEAM(p_gu);
            if (IN(p_dn)) {
#ifndef SKIP_DN
                pg8::Gemm g{G1, (const bf16_t*)(wl + (ffn ? WL_D2 : WL_D1)), MTOK, DM, DFF}; pg8::StaticOrder S; S.init(MTOK, DM, G, bid);
                if (layer == DEPTH - 1 && ffn == 1 && G == 256) {
                    pg8::EpiResidFinal E{out, out, INP(25), (float*)(ws + WS_FX), (unsigned*)(ws + WS_CTL) + 4096, 0.5f, (LAS float*)(lds + LDS_RING), (LAS float*)(lds + LDS_RINV)};
                    pg8::gemm_phase<pg8::EpiResidFinal, pg8::StaticOrder, true, true>(lds, g, S, E);
                } else {
                pg8::EpiResid E{(layer == 0 && ffn == 0) ? INP(0) : out, out, (layer == DEPTH - 1 && ffn == 1) ? nullptr : XB, SSQ, 0.5f, (LAS float*)(lds + LDS_RING)};
                pg8::gemm_phase<pg8::EpiResid, pg8::StaticOrder, true, true>(lds, g, S, E);
                }
#endif
            }
            SEAM(p_dn);
            if (ffn == 1) break;
            if (IN(pb + 2)) for (int rep = 0; rep < REP_INP; ++rep) {
#ifndef SKIP_INP
                pg8::Gemm g{XB, (const bf16_t*)(wl + WL_IN), MTOK, NIN, DM}; pg8::RinvOrder S; S.init(MTOK, NIN, G, bid); S.ssq = SSQ; S.tab = lds + LDS_RINV; S.par = 0;
                pg8::EpiScaleBf16 E{Ub, NIN, lds + LDS_RINV, 0};
                pg8::gemm_phase<pg8::EpiScaleBf16, pg8::RinvOrder, true, true>(lds, g, S, E);
#endif
            }
            SEAM(pb + 2);
            if (IN(pb + 3)) for (int rep = 0; rep < REP_MIXA; ++rep) {
#ifndef SKIP_ATTN
                for (int it = bid; it < 512; it += G) attn_item(lds, Ub, Yb, INP(7) + layer * 8, it);
#endif
#ifndef SKIP_HGA
                for (int r2 = 0; r2 < REP_HGA; ++r2) {
                    int tq = threadIdx.x; asm volatile("" : "+v"(tq));
                    float lb[8]; int hcur = (bid >> 6) & 3; hg_lb(INP(8), layer, hcur, (tq & 7) * 8, lb); HgInA cur = hg_load_a(Ub, bid < 2048 ? bid : 0, tq);
                    for (int it = bid; it < 2048; it += G) {
                        HgInA nxt = cur; if (it + G < 2048) nxt = hg_load_a(Ub, it + G, tq);
                        const int h = (it >> 6) & 3; if (h != hcur) { hg_lb(INP(8), layer, h, (tq & 7) * 8, lb); hcur = h; }
                        hgrn_a_item(lds, cur, lb, it, HS, HD); cur = nxt; }
                }
#endif
#ifndef SKIP_S5A
                for (int r2 = 0; r2 < REP_S5A; ++r2) for (int it = bid; it < 512; it += G) s5_a_item(lds, Ub, SP, BB, layer, it, SE);
#endif
                LDS_BARRIER();
            }
            SEAM(pb + 3);
            if (IN(pb + 4)) {
                int tid_s = threadIdx.x; asm volatile("" : "+v"(tid_s)); const int tid = tid_s;
                for (int e = bid * 512 + tid; e < 32 * 4096; e += G * 512) {
                    const int bh = e >> 12, kv = e & 4095, k = kv >> 6; float S = 0.f;
#pragma unroll 1
                    for (int c0 = 0; c0 < 64; c0 += 16) { float tv[16], dv[16];
#pragma unroll
                        for (int j = 0; j < 16; ++j) { const int item = bh * 64 + c0 + j; tv[j] = HS[(size_t)item * 4096 + kv]; dv[j] = HD[item * 64 + k]; }
#pragma unroll
                        for (int j = 0; j < 16; ++j) { const int item = bh * 64 + c0 + j; HS[(size_t)item * 4096 + kv] = S; S = dv[j] * S + tv[j]; } }
                }
                if (tid < 32) for (int e = bid * 32 + tid; e < 8 * 16 * 64; e += G * 32) {
                    const int b = e >> 10, gp = e & 1023; const f32x4 sp = SP[layer * 1024 + gp]; float xr = 0.f, xi = 0.f;
#pragma unroll 1
                    for (int c0 = 0; c0 < 64; c0 += 16) { f32x2 ev[16];
#pragma unroll
                        for (int j = 0; j < 16; ++j) ev[j] = SE[(size_t)(b * 64 + c0 + j) * 1024 + gp];
#pragma unroll
                        for (int j = 0; j < 16; ++j) { SE[(size_t)(b * 64 + c0 + j) * 1024 + gp] = (f32x2){xr, xi}; const float nr = sp[2] * xr - sp[3] * xi + ev[j][0], ni = sp[2] * xi + sp[3] * xr + ev[j][1]; xr = nr; xi = ni; } }
                }
            }
            SEAM(pb + 4);
            if (IN(pb + 5)) for (int rep = 0; rep < REP_MIXC; ++rep) {
#ifndef SKIP_HGC
                for (int r2 = 0; r2 < REP_HGC; ++r2) {
                    int tq = threadIdx.x; asm volatile("" : "+v"(tq));
                    float lb[8]; int hcur = (bid >> 6) & 3; hg_lb(INP(8), layer, hcur, (tq & 7) * 8, lb); HgIn cur = hg_load(Ub, HS, bid < 2048 ? bid : 0, tq, true);
                    int prev = -1, par = 0;
                    hgrn_c_init(lds);
                    for (int it = bid; it < 2048; it += G) {
                        const int h = (it >> 6) & 3; if (h != hcur) { hg_lb(INP(8), layer, h, (tq & 7) * 8, lb); hcur = h; }
                        hgrn_c_item(lds, Ub, cur, HS, it + G < 2048 ? it + G : -1, lb, it, prev, par, INP(9) + layer * 256, Yb); prev = it; par ^= 1; }
                    hgrn_c_tail(lds, Ub, prev, par ^ 1, INP(9) + layer * 256, Yb);
                }
#endif
#ifndef SKIP_S5C
                for (int it = bid; it < 512; it += G) s5_c_item(lds, Ub, SP, BB, (const bf16_t*)(ws + WS_CM), INP(17), WgT, INP(19), layer, it, SE, Yb);
#endif
            }
            SEAM(pb + 5);
            if (IN(pb + 6)) {
#ifndef SKIP_OUT
                pg8::Gemm g{Yb, (const bf16_t*)(wl + WL_OUT), MTOK, DM, DM}; pg8::StaticOrder S; S.init(MTOK, DM, G, bid);
                pg8::EpiResid E{out, out, XB, SSQ, 1.0f, (LAS float*)(lds + LDS_RING)};
                pg8::gemm_phase<pg8::EpiResid, pg8::StaticOrder, true, true>(lds, g, S, E);
#endif
            }
            SEAM(pb + 6);
        }
    }
    if (IN(N_PHASES - 1) && G != 256) {
        const int bid = bid0; int tid_f = threadIdx.x; asm volatile("" : "+v"(tid_f));
        const int lane = tid_f & 63, gw = bid * 8 + (tid_f >> 6), NGW = G * 8; const float* gn = INP(25);
        f32x4 gv[4];
#pragma unroll
        for (int j = 0; j < 4; ++j) gv[j] = ((const f32x4*)gn)[lane + 64 * j];
        for (int m = gw; m < MTOK; m += NGW) {
            f32x4* xr = (f32x4*)(out + (size_t)m * DM) + lane; f32x4 v[4]; float s = 0.f;
#pragma unroll
            for (int j = 0; j < 4; ++j) { v[j] = xr[64 * j]; s += (v[j][0] * v[j][0] + v[j][1] * v[j][1]) + (v[j][2] * v[j][2] + v[j][3] * v[j][3]); }
            s = wave_sum(s); const float ri = 1.0f / sqrtf(s * (1.0f / DM) + EPS);
#pragma unroll
            for (int j = 0; j < 4; ++j) xr[64 * j] = v[j] * ri * gv[j];
        }
    }
#undef IN
#undef SEAM
}

#ifndef ONE_LAUNCH
#define ONE_LAUNCH 1
#endif
extern "C" void kernel_launch(void* const* d_in, const int* in_sizes, int n_in, void* d_out, int out_size, void* d_ws, size_t ws_size, hipStream_t stream) {
    static int grid = 0;
    if (grid == 0) {
        if (n_in != 26 || out_size != MTOK * DM || ws_size < WS_END) { fprintf(stderr, "kernel_launch: unexpected shapes (n_in %d out %d ws %zu)\n", n_in, out_size, ws_size); grid = -1; return; }
        int dev = 0, cus = 0, per_cu = 0;
        (void)hipGetDevice(&dev); (void)hipDeviceGetAttribute(&cus, hipDeviceAttributeMultiprocessorCount, dev);
        if (hipFuncSetAttribute((const void*)fwd_kernel, hipFuncAttributeMaxDynamicSharedMemorySize, LDS_BYTES) != hipSuccess) { fprintf(stderr, "kernel_launch: hipFuncSetAttribute failed\n"); grid = -1; return; }
        if (hipOccupancyMaxActiveBlocksPerMultiprocessor(&per_cu, (const void*)fwd_kernel, 512, LDS_BYTES) != hipSuccess || per_cu < 1) { fprintf(stderr, "kernel_launch: occupancy query says %d\n", per_cu); per_cu = 1; }
        (void)hipGetLastError();
        grid = cus * per_cu;
    }
    if (grid < 0) return;
    Args a{};
    for (int i = 0; i < 26; ++i) a.in[i] = (const float*)d_in[i];
    a.out = (float*)d_out; a.ws = (unsigned char*)d_ws;
    if (hipMemsetAsync((char*)d_ws + WS_CTL, 0, 64 * 1024, stream) != hipSuccess) { fprintf(stderr, "kernel_launch: memset failed\n"); return; }
#if ONE_LAUNCH
    a.ph_lo = 0; a.ph_hi = N_PHASES;
    void* args[] = {&a};
    hipError_t e = hipLaunchCooperativeKernel((const void*)fwd_kernel, dim3(grid), dim3(512), args, LDS_BYTES, stream);
    if (e != hipSuccess) fprintf(stderr, "cooperative launch failed: %s (grid %d)\n", hipGetErrorString(e), grid);
#else
    for (int p = 0; p < N_PHASES; ++p) { a.ph_lo = p; a.ph_hi = p + 1; hipLaunchKernelGGL(fwd_kernel, dim3(grid), dim3(512), LDS_BYTES, stream, a); }
#endif
}
```
